# Optimizing an MI355X kernel written in HIP

```python
import jax, jax.numpy as jnp
from jax import lax
import numpy as np

D_MODEL = 2048
BATCH = 4
SEQ = 2048
DEPTH = 1
DEC_BATCH = 128
DEC_SEQ = 4
PAST_LEN = 16384
PAGE_SIZE = 128

D_POOL = D_MODEL
POOL_WINDOWS = (2, 4, 8, 16)
N_POOL_GROUPS = len(POOL_WINDOWS)
POOL_GROUP = D_POOL // N_POOL_GROUPS
POOL_BUF = max(POOL_WINDOWS) - 1
EXPAND = 2
D_INNER = EXPAND * D_MODEL
HEAD_DIM = 64
N_HEADS = D_INNER // HEAD_DIM
D_STATE = 128
N_GROUPS = 8
HEADS_PER_GROUP = N_HEADS // N_GROUPS
CONV_W = 4
CONV_DIM = D_INNER + 2 * N_GROUPS * D_STATE
CHUNK = 128
D_FF = 256 * ((8 * D_MODEL // 3 + 255) // 256)
N_MOD = 9
EPS = 1e-6
D_IN_PROJ = D_POOL + D_INNER + CONV_DIM + N_HEADS + 2 * D_MODEL
IN_SPLITS = (D_POOL, D_POOL + D_INNER, D_POOL + D_INNER + CONV_DIM,
             D_POOL + D_INNER + CONV_DIM + N_HEADS, D_POOL + D_INNER + CONV_DIM + N_HEADS + D_MODEL)

kernel_name = "pool_ssd_gated_macaron_adaln_step"


def rms_norm(x, g):
    xf = x.astype(jnp.float32)
    y = xf * lax.rsqrt(jnp.mean(xf * xf, axis=-1, keepdims=True) + EPS)
    return (y * g.astype(jnp.float32)).astype(x.dtype)


def modulate(x, shift, scale):
    return x * (1 + scale[:, None, :]) + shift[:, None, :]


def swiglu(x, w13, w2):
    a, b = jnp.split(x @ w13, 2, axis=-1)
    return (jax.nn.silu(a) * b) @ w2


def pool_mixer(u, buf, n_prev, w_group, scale):
    b, L, _ = u.shape
    full_raw = jnp.concatenate([buf.astype(u.dtype), u], axis=1)
    full = full_raw.astype(jnp.float32)
    cs = jnp.concatenate([jnp.zeros((b, 1, D_POOL), jnp.float32), jnp.cumsum(full, axis=1)], axis=1)
    end = cs[:, POOL_BUF + 1:]
    t = jnp.arange(L)
    outs = []
    for gi, w in enumerate(POOL_WINDOWS):
        lo, hi = gi * POOL_GROUP, (gi + 1) * POOL_GROUP
        start = cs[:, POOL_BUF + 1 - w: POOL_BUF + 1 - w + L, lo:hi]
        cnt = jnp.minimum(w, t + 1 + n_prev).astype(jnp.float32)
        outs.append((end[..., lo:hi] - start) / cnt[None, :, None])
    pooled = (jnp.concatenate(outs, axis=-1) - u.astype(jnp.float32)).astype(u.dtype)
    pg = pooled.reshape(b, L, N_POOL_GROUPS, POOL_GROUP)
    mixed = jnp.einsum('blgc,gcd->blgd', pg, w_group).reshape(b, L, D_POOL)
    return mixed * scale, full_raw[:, -POOL_BUF:]


def causal_conv(xs, buf, w, bias):
    L = xs.shape[1]
    full = jnp.concatenate([buf.astype(xs.dtype), xs], axis=1)
    out = bias + full[:, 0:L] * w[0]
    for k in range(1, CONV_W):
        out = out + full[:, k:k + L] * w[k]
    return out, full[:, -(CONV_W - 1):]


def ssd_scan(x, dt, a, bm, cm, h0):
    b, L = x.shape[:2]
    q = CHUNK if L % CHUNK == 0 else L
    nc = L // q
    f32 = jnp.float32
    xr = x.astype(f32).reshape(b, nc, q, N_GROUPS, HEADS_PER_GROUP, HEAD_DIM)
    dtr = dt.astype(f32).reshape(b, nc, q, N_GROUPS, HEADS_PER_GROUP)
    lar = dtr * a.reshape(N_GROUPS, HEADS_PER_GROUP)
    br = bm.astype(f32).reshape(b, nc, q, N_GROUPS, D_STATE)
    cr = cm.astype(f32).reshape(b, nc, q, N_GROUPS, D_STATE)
    seqs = tuple(jnp.moveaxis(v, 1, 0) for v in (xr, dtr, lar, br, cr))
    causal = jnp.tril(jnp.ones((q, q), dtype=bool))[None, :, :, None, None]

    def step(h, inp):
        xc, dtc, lac, bc, cc = inp
        s = jnp.cumsum(lac, axis=1)
        diff = s[:, :, None] - s[:, None, :]
        decay = jnp.exp(jnp.where(causal, diff, -jnp.inf))
        cb = jnp.einsum('btgn,bsgn->btsg', cc, bc)
        wts = cb[..., None] * decay * dtc[:, None]
        y = jnp.einsum('btsge,bsgep->btgep', wts, xc)
        y = y + jnp.einsum('btgn,bgepn->btgep', cc, h) * jnp.exp(s)[..., None]
        tail = jnp.exp(s[:, -1:] - s) * dtc
        h = h * jnp.exp(s[:, -1])[..., None, None] + jnp.einsum('bsge,bsgep,bsgn->bgepn', tail, xc, bc)
        return h, y

    h0r = h0.astype(f32).reshape(b, N_GROUPS, HEADS_PER_GROUP, HEAD_DIM, D_STATE)
    hT, ys = lax.scan(step, h0r, seqs)
    y = jnp.moveaxis(ys, 0, 1).reshape(b, L, N_HEADS, HEAD_DIM)
    return y, hT.reshape(b, N_HEADS, HEAD_DIM, D_STATE)


def mamba_branch(xbc_in, z, dt_raw, conv_buf, ssm_state, conv_w, conv_b, dt_bias, a_log, d_skip, ssm_norm):
    b, L, _ = z.shape
    xbc, new_conv = causal_conv(xbc_in, conv_buf, conv_w, conv_b)
    xbc = jax.nn.silu(xbc)
    xh, bm, cm = jnp.split(xbc, [D_INNER, D_INNER + N_GROUPS * D_STATE], axis=-1)
    xh = xh.reshape(b, L, N_HEADS, HEAD_DIM)
    bm = bm.reshape(b, L, N_GROUPS, D_STATE)
    cm = cm.reshape(b, L, N_GROUPS, D_STATE)
    dt = jax.nn.softplus(dt_raw.astype(jnp.float32) + dt_bias.astype(jnp.float32))
    a = -jnp.exp(a_log.astype(jnp.float32))
    y, h = ssd_scan(xh, dt, a, bm, cm, ssm_state)
    y = y + xh.astype(jnp.float32) * d_skip.astype(jnp.float32)[:, None]
    y = y.reshape(b, L, D_INNER) * jax.nn.silu(z.astype(jnp.float32))
    yg = y.reshape(b, L, N_GROUPS, D_INNER // N_GROUPS)
    yg = yg * lax.rsqrt(jnp.mean(yg * yg, axis=-1, keepdims=True) + EPS)
    y = (yg.reshape(b, L, D_INNER) * ssm_norm.astype(jnp.float32)).astype(z.dtype)
    return y, new_conv, h


def trunk(x, c, pool_bufs, n_prev, conv_bufs, ssm_states, params):
    (w_ada, b_ada, norm_ffn1, w13_ffn1, w2_ffn1, norm_mix, w_in, pool_w, pool_scale,
     conv_w, conv_b, dt_bias, a_log, d_skip, ssm_norm, w_branch_pool, w_branch_ssm, w_out,
     norm_ffn2, w13_ffn2, w2_ffn2, norm_final) = params
    h = x
    new_ssm, new_conv, new_pool = [], [], []
    for l in range(DEPTH):
        mods = jax.nn.silu(c) @ w_ada[l] + b_ada[l]
        sh1, sc1, g1, sh2, sc2, g2, sh3, sc3, g3 = jnp.split(mods, N_MOD, axis=-1)
        a1 = modulate(rms_norm(h, norm_ffn1[l]), sh1, sc1)
        h = h + 0.5 * g1[:, None] * swiglu(a1, w13_ffn1[l], w2_ffn1[l])
        u = modulate(rms_norm(h, norm_mix[l]), sh2, sc2)
        proj = u @ w_in[l]
        u_pool, z, xbc_in, dt_raw, gate_pool, gate_ssm = jnp.split(proj, IN_SPLITS, axis=-1)
        y_pool, pb = pool_mixer(u_pool, pool_bufs[l], n_prev, pool_w[l], pool_scale[l])
        y_ssm, cbuf, hs = mamba_branch(xbc_in, z, dt_raw, conv_bufs[l], ssm_states[l], conv_w[l], conv_b[l],
                                       dt_bias[l], a_log[l], d_skip[l], ssm_norm[l])
        merged = (jax.nn.sigmoid(gate_pool) * (y_pool @ w_branch_pool[l])
                  + jax.nn.sigmoid(gate_ssm) * (y_ssm @ w_branch_ssm[l]))
        h = h + g2[:, None] * (merged @ w_out[l])
        a3 = modulate(rms_norm(h, norm_ffn2[l]), sh3, sc3)
        h = h + 0.5 * g3[:, None] * swiglu(a3, w13_ffn2[l], w2_ffn2[l])
        new_ssm.append(hs)
        new_conv.append(cbuf)
        new_pool.append(pb)
    return rms_norm(h, norm_final), jnp.stack(new_ssm), jnp.stack(new_conv), jnp.stack(new_pool)


def setup_inputs(seed: int = 0) -> dict:
    key = jax.random.key(seed)
    ks = jax.random.split(key, 40)
    n = lambda k, s, sc: jax.random.normal(k, s, jnp.float32) * sc
    ones = lambda k, s: 1.0 + 0.02 * jax.random.normal(k, s, jnp.float32)
    dt0 = jnp.exp(jax.random.uniform(ks[30], (DEPTH, N_HEADS)) * (np.log(0.1) - np.log(0.001)) + np.log(0.001))
    return {
        "x_prompt": n(ks[0], (BATCH, SEQ, D_MODEL), 1.0),
        "x_sample": n(ks[1], (DEC_BATCH, DEC_SEQ, D_MODEL), 1.0),
        "c_prompt": n(ks[2], (BATCH, D_MODEL), 1.0),
        "c_sample": n(ks[3], (DEC_BATCH, D_MODEL), 1.0),
        "state_ssm": n(ks[4], (DEPTH, DEC_BATCH, N_HEADS, HEAD_DIM, D_STATE), 0.1),
        "state_conv": n(ks[5], (DEPTH, DEC_BATCH, CONV_W - 1, CONV_DIM), 1.0),
        "state_pool": n(ks[6], (DEPTH, DEC_BATCH, POOL_BUF, D_POOL), 1.0),
        "w_ada": n(ks[7], (DEPTH, D_MODEL, N_MOD * D_MODEL), 0.5 * D_MODEL ** -0.5),
        "b_ada": n(ks[8], (DEPTH, N_MOD * D_MODEL), 0.01),
        "norm_ffn1": ones(ks[9], (DEPTH, D_MODEL)),
        "w13_ffn1": n(ks[10], (DEPTH, D_MODEL, 2 * D_FF), D_MODEL ** -0.5),
        "w2_ffn1": n(ks[11], (DEPTH, D_FF, D_MODEL), D_FF ** -0.5),
        "norm_mix": ones(ks[12], (DEPTH, D_MODEL)),
        "w_in": n(ks[13], (DEPTH, D_MODEL, D_IN_PROJ), D_MODEL ** -0.5),
        "pool_w": n(ks[14], (DEPTH, N_POOL_GROUPS, POOL_GROUP, POOL_GROUP), POOL_GROUP ** -0.5),
        "pool_scale": ones(ks[15], (DEPTH, D_POOL)),
        "conv_w": n(ks[16], (DEPTH, CONV_W, CONV_DIM), CONV_W ** -0.5),
        "conv_b": n(ks[17], (DEPTH, CONV_DIM), 0.01),
        "dt_bias": dt0 + jnp.log(-jnp.expm1(-dt0)),
        "a_log": jnp.log(jax.random.uniform(ks[18], (DEPTH, N_HEADS), jnp.float32, 1.0, 16.0)),
        "d_skip": ones(ks[19], (DEPTH, N_HEADS)),
        "ssm_norm": ones(ks[20], (DEPTH, D_INNER)),
        "w_branch_pool": n(ks[21], (DEPTH, D_POOL, D_MODEL), D_POOL ** -0.5),
        "w_branch_ssm": n(ks[22], (DEPTH, D_INNER, D_MODEL), D_INNER ** -0.5),
        "w_out": n(ks[23], (DEPTH, D_MODEL, D_MODEL), D_MODEL ** -0.5),
        "norm_ffn2": ones(ks[24], (DEPTH, D_MODEL)),
        "w13_ffn2": n(ks[25], (DEPTH, D_MODEL, 2 * D_FF), D_MODEL ** -0.5),
        "w2_ffn2": n(ks[26], (DEPTH, D_FF, D_MODEL), D_FF ** -0.5),
        "norm_final": ones(ks[27], (D_MODEL,)),
    }


def reference(x_prompt, x_sample, c_prompt, c_sample, state_ssm, state_conv, state_pool,
              w_ada, b_ada, norm_ffn1, w13_ffn1, w2_ffn1, norm_mix, w_in, pool_w, pool_scale,
              conv_w, conv_b, dt_bias, a_log, d_skip, ssm_norm, w_branch_pool, w_branch_ssm, w_out,
              norm_ffn2, w13_ffn2, w2_ffn2, norm_final):
    params = (w_ada, b_ada, norm_ffn1, w13_ffn1, w2_ffn1, norm_mix, w_in, pool_w, pool_scale,
              conv_w, conv_b, dt_bias, a_log, d_skip, ssm_norm, w_branch_pool, w_branch_ssm, w_out,
              norm_ffn2, w13_ffn2, w2_ffn2, norm_final)
    b = x_prompt.shape[0]
    zero_pool = jnp.zeros((DEPTH, b, POOL_BUF, D_POOL), x_prompt.dtype)
    zero_conv = jnp.zeros((DEPTH, b, CONV_W - 1, CONV_DIM), x_prompt.dtype)
    zero_ssm = jnp.zeros((DEPTH, b, N_HEADS, HEAD_DIM, D_STATE), jnp.float32)
    y_prompt, p_ssm, p_conv, p_pool = trunk(x_prompt, c_prompt, zero_pool, 0, zero_conv, zero_ssm, params)
    y_sample, s_ssm, s_conv, s_pool = trunk(x_sample, c_sample, state_pool, min(PAST_LEN, POOL_BUF),
                                            state_conv, state_ssm, params)
    return (y_prompt, y_sample, p_ssm, p_conv, p_pool, s_ssm, s_conv, s_pool)
```

```cpp
#include <hip/hip_runtime.h>
#include <hip/hip_cooperative_groups.h>
#include <cstdio>
#include <cstdint>
namespace cg = cooperative_groups;

#ifndef MK_N_LAUNCHES
#define MK_N_LAUNCHES 1
#endif

#define LAS __attribute__((address_space(3)))
typedef unsigned short bf16_t;
typedef short bf16x8 __attribute__((ext_vector_type(8)));
typedef float f32x4 __attribute__((ext_vector_type(4)));
typedef float f32x2 __attribute__((ext_vector_type(2)));
typedef unsigned u32x4 __attribute__((ext_vector_type(4)));
typedef unsigned u32x2 __attribute__((ext_vector_type(2)));

constexpr int DM = 2048, NB = 4, SEQ = 2048, DB = 128, DS = 4;
constexpr int MP = NB * SEQ, MS = DB * DS, MT = MP + MS;
constexpr int DFF = 5632, DIN = 4096, NH = 64, HD = 64, DST = 128, NG = 8, CONVD = 6144;
constexpr int DPROJ = 16448, DPROJP = 16640;
constexpr int NMOD = 9 * DM;
constexpr int PC_POOL = 0, PC_Z = 2048, PC_XBC = 6144, PC_DT = 12288, PC_GP = 12352, PC_GS = 14400;
constexpr float EPS = 1e-6f;
constexpr size_t O_Y = 0, O_PSSM = 17825792, O_PCONV = 19922944, O_PPOOL = 19996672, O_SSSM = 20119552, O_SCONV = 87228416, O_SPOOL = 89587712, O_END = 93519872;
constexpr size_t MiB = 1u << 20;
constexpr size_t WS_CTL = 0, CTL_ZERO_BYTES = 1 * MiB, WS_SSQ = 512 * 1024;
constexpr size_t WS_W13A = 1 * MiB, WS_W2A = 45 * MiB, WS_WIN = 67 * MiB, WS_WPOOL = 132 * MiB, WS_WBP = 134 * MiB, WS_WBS = 142 * MiB, WS_WOUT = 158 * MiB,
                 WS_W13B = 166 * MiB, WS_W2B = 210 * MiB, WS_WADA = 232 * MiB, WS_TMP = 232 * MiB  , WS_AC = 304 * MiB, WS_MODS = 305 * MiB,
                 WS_ACT = 323 * MiB, WS_H = 357 * MiB, WS_DTRAW = 425 * MiB, WS_POOLED = 428 * MiB, WS_YPOOL = 462 * MiB, WS_YSSM = 496 * MiB, WS_PROJ = 564 * MiB,
                 WS_HMID = 564 * MiB  , WS_XACT = 841 * MiB  , WS_END = 943 * MiB;
constexpr int LDS_BYTES = 155648;

namespace pg8 {
constexpr int BM = 256, BK = 64, HALF = 128, HTB = HALF * BK * 2, STAGE_BYTES = 8 * HTB, NXCD = 8, WGM = 8;
__host__ __device__ __forceinline__ int lds_byte(int r, int c) { const int st = (r >> 4) * 2 + (c >> 5), rr = r & 15, cc = c & 31, ob = rr * 64 + cc * 2; return st * 1024 + (ob ^ (((ob >> 9) & 1) << 5)); }
__host__ __device__ __forceinline__ void stage_rc(int b, int& R, int& C) { const int st = b / 1024, sb = b % 1024, swz = sb ^ (((sb >> 9) & 1) << 5); R = (st >> 1) * 16 + swz / 64; C = (st & 1) * 32 + (swz % 64) / 2; }
__host__ __device__ __forceinline__ int perm32(int rho) { const int n = rho >> 4, i = rho & 15; return 8 * (i >> 2) + 4 * n + (i & 3); }

struct Unit { int pm, pn, kt0, nkt, atomic, slot; };
struct Gemm { const bf16_t* A; const bf16_t* Bt; int M, N, K; int grp_pn; size_t a_grp_bytes; int lda; };

struct StaticOrder {
    int nM, nN, nwg, G, c, nt, full, tail, S;
    __device__ __forceinline__ void init(int M, int N, int K, int G_, int c_, bool allow_split) {
        nM = M / BM; nN = N / BM; nwg = nM * nN; G = G_; c = c_; nt = K / BK;
        full = (nwg / G) * G; tail = nwg - full; S = (allow_split && tail > 0) ? G / tail : 1;
        if (S > nt / 2) S = nt / 2; if (S < 1) S = 1;
    }
    __device__ __forceinline__ void decode(int L, Unit& u) const {
        int wgid = L; { const int q = nwg / NXCD, r = nwg % NXCD, xcd = wgid % NXCD, off = wgid / NXCD; wgid = (xcd < r ? xcd * (q + 1) : r * (q + 1) + (xcd - r) * q) + off; }
        const int nig = WGM * nN, gid = wgid / nig, fm = gid * WGM, gsz = (nM - fm) < WGM ? (nM - fm) : WGM;
        u.pm = fm + ((wgid % nig) % gsz); u.pn = (wgid % nig) / gsz;
    }
    __device__ __forceinline__ bool next(int i, Unit& u) const {
        const long L = (long)i * G + c;
        if (L < full) { decode((int)L, u); u.kt0 = 0; u.nkt = nt; u.atomic = 0; u.slot = 0; return true; }
        if (L >= full + G) return false;
        const int j = (int)(L - full);
        if (S == 1) { if (j >= tail) return false; decode(full + j, u); u.kt0 = 0; u.nkt = nt; u.atomic = 0; u.slot = 0; return true; }
        const int un = j / S, pc = j % S; if (un >= tail) return false;
        decode(full + un, u); const int pairs = nt / 2, p0 = pc * pairs / S, p1 = (pc + 1) * pairs / S;
        u.kt0 = 2 * p0; u.nkt = 2 * (p1 - p0); u.atomic = 1; u.slot = j; return true;
    }
};

__device__ __forceinline__ unsigned cvt_pk_bf16(float lo, float hi) { unsigned r; asm volatile("v_cvt_pk_bf16_f32 %0, %1, %2" : "=v"(r) : "v"(lo), "v"(hi)); return r; }

template <class Epi, bool ALIGN_EPI = true>
__device__ __forceinline__ void gemm_phase(LAS unsigned char* lds, const Gemm g, const StaticOrder& S, const Epi& E) {
    int tid_ = threadIdx.x; asm volatile("" : "+v"(tid_));
    const int tid = tid_, wid = __builtin_amdgcn_readfirstlane(tid >> 6), lane = tid & 63, wr = wid >> 2, wc = wid & 3, fr = lane & 15, fq = lane >> 4;
    const int K = g.K;
    unsigned voffA[2], voffB[2];
#pragma unroll
    for (int i = 0; i < 2; ++i) { int R, C; stage_rc(tid * 16 + i * 8192, R, C); const int Rb = Epi::PERM ? ((R & ~31) + perm32(R & 31)) : R;
        voffA[i] = (unsigned)(R * (g.lda ? g.lda : K) + C) * 2u; voffB[i] = (unsigned)(Rb * K + C) * 2u; }
    const size_t kstep = (size_t)(BK * 2);
    const size_t hstep = (size_t)HALF * K * 2;
    const size_t tstep = 2 * hstep;
    const size_t hstepA = (size_t)HALF * (g.lda ? g.lda : K) * 2, tstepA = 2 * hstepA;
    const unsigned ldsw = (unsigned)wid * 1024u;
    const int aoff = lds_byte(wr * 64 + fr, fq * 8), boff = lds_byte(wc * 32 + fr, fq * 8);
#define PG8_SA(b, h) (((b) * 2 + (h)) * HTB)
#define PG8_SB(b, h) ((4 + (b) * 2 + (h)) * HTB)
#define PG8_STAGE(bufoff, gbase, voff) do { _Pragma("unroll") for (int _i = 0; _i < 2; ++_i) \
        __builtin_amdgcn_global_load_lds((const unsigned*)((const char*)(gbase) + (voff)[_i]), (LAS unsigned*)(lds + (bufoff) + ldsw + _i * 8192), 16, 0, 0); } while (0)
#define PG8_LDA(dst, b, h) do { _Pragma("unroll") for (int m = 0; m < 4; ++m) _Pragma("unroll") for (int k = 0; k < 2; ++k) dst[m][k] = *(const LAS bf16x8*)(lds + PG8_SA(b, h) + aoff + m * 2048 + k * 1024); } while (0)
#define PG8_LDB(dst, b, h) do { _Pragma("unroll") for (int n = 0; n < 2; ++n) _Pragma("unroll") for (int k = 0; k < 2; ++k) dst[n][k] = *(const LAS bf16x8*)(lds + PG8_SB(b, h) + boff + n * 2048 + k * 1024); } while (0)
#define PG8_MMA(ai, bj, At, Bt) do { __builtin_amdgcn_s_setprio(1); _Pragma("unroll") for (int m = 0; m < 4; ++m) _Pragma("unroll") for (int n = 0; n < 2; ++n) _Pragma("unroll") for (int k = 0; k < 2; ++k) \
        acc[ai][bj][m][n] = __builtin_amdgcn_mfma_f32_16x16x32_bf16(Bt[n][k], At[m][k], acc[ai][bj][m][n], 0, 0, 0); __builtin_amdgcn_s_setprio(0); } while (0)
#define PG8_WAIT_V(n) asm volatile("s_waitcnt vmcnt(" #n ")" ::: "memory")
#define PG8_WAIT_L(n) asm volatile("s_waitcnt lgkmcnt(" #n ")" ::: "memory")
#define PG8_BAR __builtin_amdgcn_s_barrier()
#define PG8_SCHED __builtin_amdgcn_sched_barrier(0)
#define PG8_ABASE(u) ((const char*)g.A + (size_t)(u).pm * tstepA + (size_t)(u).kt0 * kstep + (g.grp_pn ? (size_t)((u).pn / g.grp_pn) * g.a_grp_bytes : (size_t)0))
#define PG8_BBASE(u) ((const char*)g.Bt + (size_t)(u).pn * tstep + (size_t)(u).kt0 * kstep)
    Unit cur, nxt; int ui = 0;
    if (!S.next(0, cur)) return;
    f32x4 acc[2][2][4][2];
#pragma unroll
    for (int a = 0; a < 2; ++a)
#pragma unroll
        for (int b = 0; b < 2; ++b)
#pragma unroll
            for (int m = 0; m < 4; ++m)
#pragma unroll
                for (int n = 0; n < 2; ++n) acc[a][b][m][n] = (f32x4){0.f, 0.f, 0.f, 0.f};
    bf16x8 At[4][2], B0[2][2], B1[2][2];
    const char* cA = PG8_ABASE(cur); const char* cB = PG8_BBASE(cur); int nt = cur.nkt;
    PG8_STAGE(PG8_SB(0, 0), cB, voffB); PG8_STAGE(PG8_SB(0, 1), cB + hstep, voffB); PG8_STAGE(PG8_SA(0, 0), cA, voffA); PG8_STAGE(PG8_SA(0, 1), cA + hstepA, voffA);
    if (wr == 1) PG8_BAR;
    PG8_WAIT_V(2); PG8_BAR;
    PG8_STAGE(PG8_SB(1, 0), cB + kstep, voffB); PG8_STAGE(PG8_SA(1, 0), cA + kstep, voffA); PG8_STAGE(PG8_SB(1, 1), cB + hstep + kstep, voffB);
    PG8_WAIT_V(6); PG8_BAR;
    for (;;) {
        const bool has_next = S.next(ui + 1, nxt);
        const char* nA = has_next ? PG8_ABASE(nxt) : cA; const char* nB = has_next ? PG8_BBASE(nxt) : cB;
        for (int t = 0; t < nt; t += 2) {
            const bool last = (t == nt - 2);
            const char* a1 = cA + (size_t)(t + 1) * kstep;
            const char* a2 = last ? nA : cA + (size_t)(t + 2) * kstep; const char* b2 = last ? nB : cB + (size_t)(t + 2) * kstep;
            const char* a3 = a2 + kstep; const char* b3 = b2 + kstep;
            PG8_LDB(B0, 0, 0); PG8_LDB(B1, 0, 1); PG8_SCHED; PG8_LDA(At, 0, 0); PG8_STAGE(PG8_SA(1, 1), a1 + hstepA, voffA);
            PG8_WAIT_V(8); PG8_WAIT_L(0); PG8_BAR; PG8_MMA(0, 0, At, B0); PG8_MMA(0, 1, At, B1); PG8_BAR; PG8_SCHED;
            PG8_LDA(At, 0, 1); PG8_STAGE(PG8_SB(0, 0), b2, voffB); PG8_STAGE(PG8_SB(0, 1), b2 + hstep, voffB); PG8_STAGE(PG8_SA(0, 0), a2, voffA);
            PG8_WAIT_V(8); PG8_WAIT_L(0); PG8_BAR; PG8_MMA(1, 0, At, B0); PG8_MMA(1, 1, At, B1); PG8_BAR; PG8_SCHED;
            PG8_LDB(B0, 1, 0); PG8_LDB(B1, 1, 1); PG8_SCHED; PG8_LDA(At, 1, 0); PG8_STAGE(PG8_SA(0, 1), a2 + hstepA, voffA);
            PG8_WAIT_V(8); PG8_WAIT_L(0); PG8_BAR; PG8_MMA(0, 0, At, B0); PG8_MMA(0, 1, At, B1); PG8_BAR; PG8_SCHED;
            PG8_LDA(At, 1, 1); PG8_STAGE(PG8_SB(1, 0), b3, voffB); PG8_STAGE(PG8_SB(1, 1), b3 + hstep, voffB); PG8_STAGE(PG8_SA(1, 0), a3, voffA);
            PG8_WAIT_V(8); PG8_WAIT_L(0); PG8_BAR; PG8_MMA(1, 0, At, B0); PG8_MMA(1, 1, At, B1); PG8_BAR; PG8_SCHED;
        }
        if constexpr (ALIGN_EPI) { if (wr == 0) PG8_BAR; }
        __builtin_amdgcn_sched_barrier(0); asm volatile("s_nop 15\n\ts_nop 3"); __builtin_amdgcn_sched_barrier(0);
        E(acc, cur, wr, wc, fr, fq);
        if (!has_next) break;
#pragma unroll
        for (int a = 0; a < 2; ++a)
#pragma unroll
            for (int b = 0; b < 2; ++b)
#pragma unroll
                for (int m = 0; m < 4; ++m)
#pragma unroll
                    for (int n = 0; n < 2; ++n) acc[a][b][m][n] = (f32x4){0.f, 0.f, 0.f, 0.f};
        cur = nxt; cA = nA; cB = nB; nt = cur.nkt; ++ui;
        if constexpr (ALIGN_EPI) { if (wr == 1) PG8_BAR; }
    }
    PG8_WAIT_V(0);
    if constexpr (!ALIGN_EPI) { if (wr == 0) PG8_BAR; }
    PG8_BAR;
#undef PG8_SA
#undef PG8_SB
#undef PG8_STAGE
#undef PG8_LDA
#undef PG8_LDB
#undef PG8_MMA
#undef PG8_WAIT_V
#undef PG8_WAIT_L
#undef PG8_BAR
#undef PG8_SCHED
#undef PG8_ABASE
#undef PG8_BBASE
}
}

typedef __bf16 bf16x2_t __attribute__((ext_vector_type(2)));
__device__ __forceinline__ unsigned pk2(float lo, float hi) { const f32x2 v = {lo, hi}; const bf16x2_t b = __builtin_convertvector(v, bf16x2_t); return __builtin_bit_cast(unsigned, b); }
__device__ __forceinline__ unsigned f2bf(float f) { return pk2(f, f) & 0xffffu; }
__device__ __forceinline__ float bflo(unsigned w) { return __builtin_bit_cast(float, w << 16); }
__device__ __forceinline__ float bfhi(unsigned w) { return __builtin_bit_cast(float, w & 0xffff0000u); }
__device__ __forceinline__ float bf1(bf16_t v) { return __builtin_bit_cast(float, (unsigned)v << 16); }
__device__ __forceinline__ float sigmoidf_(float v) { return 1.0f / (1.0f + __expf(-v)); }
__device__ __forceinline__ float siluf_(float v) { return v / (1.0f + __expf(-v)); }
__device__ __forceinline__ float sigmoid_fast(float v) { return __builtin_amdgcn_rcpf(1.0f + __expf(-v)); }
__device__ __forceinline__ float silu_fast(float v) { return v * __builtin_amdgcn_rcpf(1.0f + __expf(-v)); }
__device__ __forceinline__ float softplusf_(float v) { return v > 20.f ? v : log1pf(__expf(v)); }
__device__ __forceinline__ float wave_sum(float v) {
#pragma unroll
    for (int o = 1; o < 64; o <<= 1) v += __shfl_xor(v, o);
    return v;
}
__device__ __forceinline__ int rowb(int m) { return m < MP ? (m >> 11) : 4 + ((m - MP) >> 2); }
#define LDS_WAIT() asm volatile("s_waitcnt lgkmcnt(0)" ::: "memory")
#define MFMA_SETTLE4(a, b, c, d) do { __builtin_amdgcn_sched_barrier(0); asm volatile("s_nop 15\n\ts_nop 3"); __builtin_amdgcn_sched_barrier(0); } while (0)
#define MFMA_SETTLE1(a) MFMA_SETTLE4(a, a, a, a)

using pg8::Unit; using pg8::HALF; using pg8::BM; using pg8::cvt_pk_bf16;
__device__ __forceinline__ void acc4(float* p, const f32x4 v) { *(f32x4*)p = *(const f32x4*)p + v; }
struct EpiMods { static constexpr bool PERM = false; float* O;
    __device__ __forceinline__ void operator()(const f32x4 (&acc)[2][2][4][2], const Unit& u, int wr, int wc, int fr, int fq) const {
        const int col0 = u.pn * BM + wc * 32 + 4 * fq;
#pragma unroll
        for (int ai = 0; ai < 2; ++ai)
#pragma unroll
            for (int m = 0; m < 4; ++m) { const int r = u.pm * BM + ai * HALF + wr * 64 + m * 16 + fr; if (r >= 132) continue;
#pragma unroll
                for (int bj = 0; bj < 2; ++bj)
#pragma unroll
                    for (int n = 0; n < 2; ++n) acc4(O + (size_t)r * NMOD + col0 + bj * HALF + n * 16, acc[ai][bj][m][n]); }
    }
};
struct EpiSwiglu { static constexpr bool PERM = true; bf16_t* O;
    __device__ __forceinline__ void operator()(const f32x4 (&acc)[2][2][4][2], const Unit& u, int wr, int wc, int fr, int fq) const {
        const int col0 = u.pn * HALF + wc * 32 + 8 * fq;
#pragma unroll
        for (int ai = 0; ai < 2; ++ai)
#pragma unroll
            for (int m = 0; m < 4; ++m) { const int r = u.pm * BM + ai * HALF + wr * 64 + m * 16 + fr;
                float o[8];
#pragma unroll
                for (int n = 0; n < 2; ++n)
#pragma unroll
                    for (int v = 0; v < 4; ++v) o[4 * n + v] = silu_fast(acc[ai][0][m][n][v]) * acc[ai][1][m][n][v];
                u32x4 w; w.x = cvt_pk_bf16(o[0], o[1]); w.y = cvt_pk_bf16(o[2], o[3]); w.z = cvt_pk_bf16(o[4], o[5]); w.w = cvt_pk_bf16(o[6], o[7]);
                *(u32x4*)(O + (size_t)r * DFF + col0) = w; }
    }
};
struct EpiResid { static constexpr bool PERM = false; float* out; const float* gate; float coef; float* part; const float* base_p; const float* base_s;
    __device__ __forceinline__ void operator()(const f32x4 (&acc)[2][2][4][2], const Unit& u, int wr, int wc, int fr, int fq) const {
        const int col0 = u.pn * BM + wc * 32 + 4 * fq;
        const bool uni = u.pm < MP / BM;
        f32x4 gq[2][2];
#pragma unroll
        for (int bj = 0; bj < 2; ++bj)
#pragma unroll
            for (int n = 0; n < 2; ++n) gq[bj][n] = uni ? *(const f32x4*)(gate + (size_t)(u.pm >> 3) * NMOD + col0 + bj * HALF + n * 16) : (f32x4){0.f, 0.f, 0.f, 0.f};
#pragma unroll
        for (int ai = 0; ai < 2; ++ai)
#pragma unroll
            for (int m = 0; m < 4; ++m) { const int r = u.pm * BM + ai * HALF + wr * 64 + m * 16 + fr;
                const float* grow = gate + (size_t)rowb(r) * NMOD; float* orow = out + (size_t)r * DM; const float* brow = base_p ? (r < MP ? base_p + (size_t)r * DM : base_s + (size_t)(r - MP) * DM) : orow; bf16_t* prow = (bf16_t*)part + (size_t)u.slot * 65536 + (size_t)(r & 255) * 256 - u.pn * BM;
#pragma unroll
                for (int bj = 0; bj < 2; ++bj)
#pragma unroll
                    for (int n = 0; n < 2; ++n) { const int c = col0 + bj * HALF + n * 16;
                        const f32x4 gv = uni ? gq[bj][n] : *(const f32x4*)(grow + c); const f32x4 inc = coef * gv * acc[ai][bj][m][n];
                        if (u.atomic) { u32x2 pw; pw.x = pk2(inc.x, inc.y); pw.y = pk2(inc.z, inc.w); *(u32x2*)(prow + c) = pw; } else *(f32x4*)(orow + c) = *(const f32x4*)(brow + c) + inc; } }
    }
};
struct EpiProj { static constexpr bool PERM = true; bf16_t* O; float* dtraw;
    __device__ __forceinline__ void operator()(const f32x4 (&acc)[2][2][4][2], const Unit& u, int wr, int wc, int fr, int fq) const {
        const int col0 = u.pn * BM + wc * 32 + 8 * fq;
        const bool dtt = (u.pn == PC_DT / BM) && (wc < 2);
        const bool zt = (u.pn >= PC_Z / BM) && (u.pn < PC_XBC / BM);
#pragma unroll
        for (int ai = 0; ai < 2; ++ai)
#pragma unroll
            for (int m = 0; m < 4; ++m) { const int r = u.pm * BM + ai * HALF + wr * 64 + m * 16 + fr;
#pragma unroll
                for (int bj = 0; bj < 2; ++bj) { f32x4 v0 = acc[ai][bj][m][0], v1 = acc[ai][bj][m][1];
                    if (zt) { v0[0] = siluf_(v0[0]); v0[1] = siluf_(v0[1]); v0[2] = siluf_(v0[2]); v0[3] = siluf_(v0[3]); v1[0] = siluf_(v1[0]); v1[1] = siluf_(v1[1]); v1[2] = siluf_(v1[2]); v1[3] = siluf_(v1[3]); }
                    u32x4 w; w.x = cvt_pk_bf16(v0[0], v0[1]); w.y = cvt_pk_bf16(v0[2], v0[3]); w.z = cvt_pk_bf16(v1[0], v1[1]); w.w = cvt_pk_bf16(v1[2], v1[3]);
                    *(u32x4*)(O + (size_t)r * DPROJP + col0 + bj * HALF) = w;
                    if (bj == 0 && dtt) { float* d = dtraw + (size_t)r * 64 + wc * 32 + 8 * fq; *(f32x4*)d = v0; *(f32x4*)(d + 4) = v1; } } }
    }
};
struct EpiPlain { static constexpr bool PERM = true; bf16_t* O;
    __device__ __forceinline__ void operator()(const f32x4 (&acc)[2][2][4][2], const Unit& u, int wr, int wc, int fr, int fq) const {
        const int col0 = u.pn * BM + wc * 32 + 8 * fq;
#pragma unroll
        for (int bj = 0; bj < 2; ++bj)
#pragma unroll
            for (int ai = 0; ai < 2; ++ai)
#pragma unroll
                for (int m = 0; m < 4; ++m) { const int r = u.pm * BM + ai * HALF + wr * 64 + m * 16 + fr;
                    const f32x4 v0 = acc[ai][bj][m][0], v1 = acc[ai][bj][m][1];
                    u32x4 w; w.x = cvt_pk_bf16(v0[0], v0[1]); w.y = cvt_pk_bf16(v0[2], v0[3]); w.z = cvt_pk_bf16(v1[0], v1[1]); w.w = cvt_pk_bf16(v1[2], v1[3]);
                    *(u32x4*)(O + (size_t)r * DM + col0 + bj * HALF) = w; }
    }
};
struct EpiScale { static constexpr bool PERM = true; bf16_t* O; const float* scale;
    __device__ __forceinline__ void operator()(const f32x4 (&acc)[2][2][4][2], const Unit& u, int wr, int wc, int fr, int fq) const {
        const int col0 = u.pn * BM + wc * 32 + 8 * fq;
#pragma unroll
        for (int bj = 0; bj < 2; ++bj) { const f32x4 s0 = *(const f32x4*)(scale + col0 + bj * HALF), s1 = *(const f32x4*)(scale + col0 + bj * HALF + 4);
#pragma unroll
            for (int ai = 0; ai < 2; ++ai)
#pragma unroll
                for (int m = 0; m < 4; ++m) { const int r = u.pm * BM + ai * HALF + wr * 64 + m * 16 + fr;
                    const f32x4 v0 = acc[ai][bj][m][0] * s0, v1 = acc[ai][bj][m][1] * s1;
                    u32x4 w; w.x = cvt_pk_bf16(v0[0], v0[1]); w.y = cvt_pk_bf16(v0[2], v0[3]); w.z = cvt_pk_bf16(v1[0], v1[1]); w.w = cvt_pk_bf16(v1[2], v1[3]);
                    *(u32x4*)(O + (size_t)r * DM + col0 + bj * HALF) = w; } }
    }
};
template <bool MERGE> struct EpiGate { static constexpr bool PERM = true; const bf16_t* proj; int gcol; float* tmp; bf16_t* merged; float* part;
    __device__ __forceinline__ void operator()(const f32x4 (&acc)[2][2][4][2], const Unit& u, int wr, int wc, int fr, int fq) const {
        const int col0 = u.pn * BM + wc * 32 + 8 * fq;
#pragma unroll
        for (int ai = 0; ai < 2; ++ai)
#pragma unroll
            for (int m = 0; m < 4; ++m) { const int r = u.pm * BM + ai * HALF + wr * 64 + m * 16 + fr;
#pragma unroll
                for (int bj = 0; bj < 2; ++bj) { const int c = col0 + bj * HALF;
                    const u32x4 gw = *(const u32x4*)(proj + (size_t)r * DPROJP + gcol + c);
                    f32x4 v0 = acc[ai][bj][m][0], v1 = acc[ai][bj][m][1];
                    v0[0] *= sigmoid_fast(bflo(gw.x)); v0[1] *= sigmoid_fast(bfhi(gw.x)); v0[2] *= sigmoid_fast(bflo(gw.y)); v0[3] *= sigmoid_fast(bfhi(gw.y));
                    v1[0] *= sigmoid_fast(bflo(gw.z)); v1[1] *= sigmoid_fast(bfhi(gw.z)); v1[2] *= sigmoid_fast(bflo(gw.w)); v1[3] *= sigmoid_fast(bfhi(gw.w));
                    float* tp = tmp + (size_t)r * DM + c;
                    if (u.atomic) { bf16_t* pp = (bf16_t*)part + (size_t)u.slot * 65536 + (size_t)(r & 255) * 256 + (c - u.pn * BM); u32x4 pw; pw.x = pk2(v0[0], v0[1]); pw.y = pk2(v0[2], v0[3]); pw.z = pk2(v1[0], v1[1]); pw.w = pk2(v1[2], v1[3]); *(u32x4*)pp = pw; }
                    else if constexpr (!MERGE) { *(f32x4*)tp = v0; *(f32x4*)(tp + 4) = v1; }
                    else { v0 += *(const f32x4*)tp; v1 += *(const f32x4*)(tp + 4);
                        u32x4 w; w.x = cvt_pk_bf16(v0[0], v0[1]); w.y = cvt_pk_bf16(v0[2], v0[3]); w.z = cvt_pk_bf16(v1[0], v1[1]); w.w = cvt_pk_bf16(v1[2], v1[3]);
                        *(u32x4*)(merged + (size_t)r * DM + c) = w; } } }
    }
};

struct Args { const float* in[29]; float* out; unsigned char* ws; int ph_lo, ph_hi, coop, pad; };
struct Ctx { LAS unsigned char* lds; int tid, lane, wave, G, bid; };

struct TItem { const float* src; bf16_t* dst; int N, K; };
__device__ __forceinline__ int rm_swiglu(int n0) { return n0 < DFF ? (n0 >> 7) * 256 + (n0 & 127) : ((n0 - DFF) >> 7) * 256 + 128 + ((n0 - DFF) & 127); }
__device__ __forceinline__ TItem titem(const float* W, int K, int N, bf16_t* WT, int item, int row_off, bool swiglu) {
    const int nblk = N / 32, kb = item / nblk, nb = item % nblk, k0 = 64 * kb, n0 = 32 * nb;
    TItem t; t.src = W + (size_t)k0 * N + n0; t.dst = WT + (size_t)(swiglu ? rm_swiglu(n0) : row_off + n0) * K + k0; t.N = N; t.K = K; return t;
}
__device__ __forceinline__ TItem p0_decode(const Args& a, int r) {
    unsigned char* ws = a.ws;
    constexpr int I_ADA = 32 * (NMOD / 32), I_13 = 32 * (2 * DFF / 32), I_2 = (DFF / 64) * (DM / 32), I_IN = 32 * (DPROJ / 32), I_PW = 8 * 16, I_BP = 32 * 64, I_BS = 64 * 64;
    if (r < I_ADA) return titem(a.in[7], DM, NMOD, (bf16_t*)(ws + WS_WADA), r, 0, false); r -= I_ADA;
    if (r < I_13) return titem(a.in[10], DM, 2 * DFF, (bf16_t*)(ws + WS_W13A), r, 0, true); r -= I_13;
    if (r < I_2) return titem(a.in[11], DFF, DM, (bf16_t*)(ws + WS_W2A), r, 0, false); r -= I_2;
    if (r < I_IN) return titem(a.in[13], DM, DPROJ, (bf16_t*)(ws + WS_WIN), r, 0, false); r -= I_IN;
    if (r < 4 * I_PW) { const int g = r / I_PW; return titem(a.in[14] + (size_t)g * 512 * 512, 512, 512, (bf16_t*)(ws + WS_YPOOL + 16 * MiB), r % I_PW, g * 512, false); } r -= 4 * I_PW;
    if (r < I_BP) return titem(a.in[22], DM, DM, (bf16_t*)(ws + WS_WBP), r, 0, false); r -= I_BP;
    if (r < I_BS) return titem(a.in[23], DIN, DM, (bf16_t*)(ws + WS_WBS), r, 0, false); r -= I_BS;
    if (r < I_BP) return titem(a.in[24], DM, DM, (bf16_t*)(ws + WS_WOUT), r, 0, false); r -= I_BP;
    if (r < I_13) return titem(a.in[26], DM, 2 * DFF, (bf16_t*)(ws + WS_W13B), r, 0, true); r -= I_13;
    return titem(a.in[27], DFF, DM, (bf16_t*)(ws + WS_W2B), r, 0, false);
}
constexpr int P0_I_ADA = 32 * (NMOD / 32), P0_I_13 = 32 * (2 * DFF / 32), P0_I_2 = (DFF / 64) * (DM / 32), P0_I_IN = 32 * (DPROJ / 32), P0_I_PW = 8 * 16, P0_I_BP = 32 * 64, P0_I_BS = 64 * 64;
constexpr int P0_NITEMS = P0_I_ADA + 2 * P0_I_13 + 2 * P0_I_2 + P0_I_IN + 4 * P0_I_PW + 2 * P0_I_BP + P0_I_BS;
constexpr int P0_EARLY = P0_NITEMS - P0_I_13 - P0_I_2;
constexpr int P0_DEFER_A = P0_EARLY + 4608;
__device__ __forceinline__ void convert_range(const Ctx& F, const Args& a, int it0, int it_end, int stride, int skip_lo = 1 << 30, int skip_len = 0) {
    LAS float* scr = (LAS float*)(F.lds + F.wave * 16384);
    const int lane = F.lane, lr = lane >> 3, lc = 4 * (lane & 7);
    int it = it0;
    f32x4 R[8]; TItem cur;
#define P0_LOAD(T, RR) do { _Pragma("unroll") for (int i = 0; i < 8; ++i) RR[i] = __builtin_nontemporal_load((const f32x4*)((T).src + (size_t)(8 * i + lr) * (T).N + lc)); } while (0)
    if (it < it_end) { cur = p0_decode(a, it >= skip_lo ? it + skip_len : it); P0_LOAD(cur, R); }
    while (it < it_end) {
        const int nit = it + stride; f32x4 Rn[8]; TItem nxt = cur;
        if (nit < it_end) { nxt = p0_decode(a, nit >= skip_lo ? nit + skip_len : nit); P0_LOAD(nxt, Rn); }
#pragma unroll
        for (int i = 0; i < 8; ++i) { LAS float* q = scr + (8 * i + lr) * 33 + lc; q[0] = R[i].x; q[1] = R[i].y; q[2] = R[i].z; q[3] = R[i].w; }
        LDS_WAIT(); asm volatile("" ::: "memory");
        { const int c = lane & 7;
#pragma unroll
          for (int j = 0; j < 4; ++j) { const int n = (lane >> 3) + 8 * j; const LAS float* q = scr + (8 * c) * 33 + n;
              u32x4 o; o.x = pk2(q[0 * 33], q[1 * 33]); o.y = pk2(q[2 * 33], q[3 * 33]); o.z = pk2(q[4 * 33], q[5 * 33]); o.w = pk2(q[6 * 33], q[7 * 33]);
              *(u32x4*)(cur.dst + (size_t)n * cur.K + 8 * c) = o; } }
        LDS_WAIT(); asm volatile("" ::: "memory");
#pragma unroll
        for (int i = 0; i < 8; ++i) R[i] = Rn[i];
        cur = nxt; it = nit;
    }
#undef P0_LOAD
}
__device__ __forceinline__ void p0_prologue(const Ctx& F, const Args& a, int part, int wg0, int nwg) {
    unsigned char* ws = a.ws;
    const int gw = (F.bid - wg0) * 8 + F.wave, NGW = nwg * 8;
    constexpr int BP_LO = P0_I_ADA + P0_I_13 + P0_I_2 + P0_I_IN + 4 * P0_I_PW;
    if (part == 0) { convert_range(F, a, gw, P0_I_ADA, NGW); convert_range(F, a, BP_LO + gw, BP_LO + P0_I_BP, NGW); }
    else convert_range(F, a, gw + P0_I_ADA, P0_EARLY - P0_I_BP, NGW, BP_LO, P0_I_BP);
    if (part != 0) return;
    { u32x4* z = (u32x4*)((bf16_t*)(ws + WS_WIN) + (size_t)DPROJ * DM); const int n16 = (DPROJP - DPROJ) * DM * 2 / 16;
      for (int i = F.bid * 512 + F.tid; i < n16; i += F.G * 512) z[i] = (u32x4){0u, 0u, 0u, 0u}; }
    { bf16_t* pws = (bf16_t*)(ws + WS_WPOOL); for (int i = F.bid * 512 + F.tid; i < 4 * 512 * 512 / 4; i += F.G * 512) { const int e = i * 4, cc = e >> 9, d = e & 511;
        const f32x4 w4 = *(const f32x4*)(a.in[14] + e), s4 = *(const f32x4*)(a.in[15] + (cc >> 9) * 512 + d); u32x2 o; o.x = pk2(w4.x * s4.x, w4.y * s4.y); o.y = pk2(w4.z * s4.z, w4.w * s4.w); *(u32x2*)(pws + e) = o; } }
    { float* mods = (float*)(ws + WS_MODS); for (int i = F.bid * 512 + F.tid; i < 132 * NMOD / 4; i += F.G * 512) { const int c = (i % (NMOD / 4)) * 4; *(f32x4*)(mods + (size_t)(i / (NMOD / 4)) * NMOD + c) = *(const f32x4*)(a.in[8] + c); } }
    { bf16_t* Ac = (bf16_t*)(ws + WS_AC);
      for (int i = F.bid * 512 + F.tid; i < 256 * DM / 2; i += F.G * 512) { const int r = i / (DM / 2), c = (i % (DM / 2)) * 2;
          unsigned w = 0u;
          if (r < 132) { const float* src = r < 4 ? a.in[2] + (size_t)r * DM : a.in[3] + (size_t)(r - 4) * DM; w = pk2(siluf_(src[c]), siluf_(src[c + 1])); }
          *(unsigned*)(Ac + (size_t)r * DM + c) = w; } }
}

__device__ __forceinline__ void norm_mod_rows(const Ctx& F, const float* xp, const float* xs, const float* gamma, const float* mods, int sh_off, int sc_off, bf16_t* out, const float* fixb_p, const float* fixb_s, const float* part, int S, const LAS int* tmap) {
    const int gw = F.bid * 8 + F.wave, NGW = F.G * 8;
    f32x4 gm[8];
#pragma unroll
    for (int j = 0; j < 8; ++j) gm[j] = *(const f32x4*)(gamma + 4 * F.lane + 256 * j);
    for (int m = gw; m < MT; m += NGW) {
        float* xrow = (float*)((m < MP) ? xp + (size_t)m * DM : xs + (size_t)(m - MP) * DM);
        const f32x4* xr = (const f32x4*)xrow + F.lane;
        f32x4 v[8]; float s = 0.f;
#pragma unroll
        for (int j = 0; j < 8; ++j) v[j] = xr[64 * j];
        if (S > 1) {
#pragma unroll
            for (int j = 0; j < 8; ++j) { const int un = tmap[(m >> 8) * 8 + j]; if (un >= 0) { f32x4 q = (f32x4){0.f, 0.f, 0.f, 0.f};
                const bf16_t* pb_ = (const bf16_t*)part + (size_t)(un * S) * 65536 + (m & 255) * 256 + 4 * F.lane;
                if (S == 16) {
                    u32x2 pw[16];
#pragma unroll
                    for (int pc = 0; pc < 16; ++pc) pw[pc] = *(const u32x2*)(pb_ + (size_t)pc * 65536);
#pragma unroll
                    for (int pc = 0; pc < 16; ++pc) q += (f32x4){bflo(pw[pc].x), bfhi(pw[pc].x), bflo(pw[pc].y), bfhi(pw[pc].y)};
                } else for (int pc = 0; pc < S; ++pc) { const u32x2 pw = *(const u32x2*)(pb_ + (size_t)pc * 65536); q += (f32x4){bflo(pw.x), bfhi(pw.x), bflo(pw.y), bfhi(pw.y)}; }
                if (fixb_p) v[j] = ((const f32x4*)((m < MP) ? fixb_p + (size_t)m * DM : fixb_s + (size_t)(m - MP) * DM))[F.lane + 64 * j];
                v[j] += q; ((f32x4*)xrow)[F.lane + 64 * j] = v[j]; } } }
        const float* mr = mods + (size_t)rowb(m) * NMOD;
        f32x4 scv[8], shv[8];
#pragma unroll
        for (int j = 0; j < 8; ++j) { const int c = 4 * F.lane + 256 * j; scv[j] = *(const f32x4*)(mr + sc_off + c); shv[j] = *(const f32x4*)(mr + sh_off + c); }
#pragma unroll
        for (int j = 0; j < 8; ++j) s += (v[j].x * v[j].x + v[j].y * v[j].y) + (v[j].z * v[j].z + v[j].w * v[j].w);
        const float rinv = 1.0f / sqrtf(wave_sum(s) * (1.0f / DM) + EPS);
        u32x2* o8 = (u32x2*)(out + (size_t)m * DM) + F.lane;
#pragma unroll
        for (int j = 0; j < 8; ++j) {
            const f32x4 y = (v[j] * rinv * gm[j]) * (1.0f + scv[j]) + shv[j];
            u32x2 w; w.x = pk2(y.x, y.y); w.y = pk2(y.z, y.w); o8[64 * j] = w; }
    }
}
__device__ __forceinline__ void final_norm_rows(const Ctx& F, const float* h, const float* gamma, float* out, const float* part, int S, const LAS int* tmap) {
    const int gw = F.bid * 8 + F.wave, NGW = F.G * 8;
    f32x4 gm[8];
#pragma unroll
    for (int j = 0; j < 8; ++j) gm[j] = *(const f32x4*)(gamma + 4 * F.lane + 256 * j);
    for (int m = gw; m < MT; m += NGW) {
        const f32x4* xr = (const f32x4*)(h + (size_t)m * DM) + F.lane;
        f32x4 v[8]; float s = 0.f;
#pragma unroll
        for (int j = 0; j < 8; ++j) v[j] = xr[64 * j];
        if (S > 1) {
#pragma unroll
            for (int j = 0; j < 8; ++j) { const int un = tmap[(m >> 8) * 8 + j]; if (un >= 0) { f32x4 q = (f32x4){0.f, 0.f, 0.f, 0.f};
                const bf16_t* pb_ = (const bf16_t*)part + (size_t)(un * S) * 65536 + (m & 255) * 256 + 4 * F.lane;
                if (S == 16) {
                    u32x2 pw[16];
#pragma unroll
                    for (int pc = 0; pc < 16; ++pc) pw[pc] = *(const u32x2*)(pb_ + (size_t)pc * 65536);
#pragma unroll
                    for (int pc = 0; pc < 16; ++pc) q += (f32x4){bflo(pw[pc].x), bfhi(pw[pc].x), bflo(pw[pc].y), bfhi(pw[pc].y)};
                } else for (int pc = 0; pc < S; ++pc) { const u32x2 pw = *(const u32x2*)(pb_ + (size_t)pc * 65536); q += (f32x4){bflo(pw.x), bfhi(pw.x), bflo(pw.y), bfhi(pw.y)}; }
                v[j] += q; } } }
#pragma unroll
        for (int j = 0; j < 8; ++j) s += (v[j].x * v[j].x + v[j].y * v[j].y) + (v[j].z * v[j].z + v[j].w * v[j].w);
        const float rinv = 1.0f / sqrtf(wave_sum(s) * (1.0f / DM) + EPS);
        f32x4* o = (f32x4*)(out + (size_t)m * DM) + F.lane;
#pragma unroll
        for (int j = 0; j < 8; ++j) o[64 * j] = v[j] * rinv * gm[j];
    }
}

constexpr int SP = 272;
constexpr int SC_XT = 0, SC_BN = 34816, SC_WM = 69632, SC_HB = 104448, SC_S = 139264, SC_DT = SC_S + 512, SC_W = SC_S + 1024, SC_E = SC_S + 1536, SC_END = SC_S + 2048;
static_assert(SC_END <= LDS_BYTES - 64, "scan LDS map");

template <int W> __device__ __forceinline__ void pool_prompt_run(const bf16_t* U, bf16_t* P, float* OPp, int t0) {
    u32x2 r[W - 1 + 16];
#pragma unroll
    for (int i = 0; i < W - 1 + 16; ++i) { const int row = t0 - (W - 1) + i; r[i] = row >= 0 ? *(const u32x2*)(U + (ptrdiff_t)row * DPROJP) : (u32x2){0u, 0u}; }
    float s0 = 0.f, s1 = 0.f, s2 = 0.f, s3 = 0.f;
#pragma unroll
    for (int i = 0; i < W - 1; ++i) { s0 += bflo(r[i].x); s1 += bfhi(r[i].x); s2 += bflo(r[i].y); s3 += bfhi(r[i].y); }
#pragma unroll
    for (int j = 0; j < 16; ++j) { const int t = t0 + j; const u32x2 q = r[W - 1 + j]; const float u0 = bflo(q.x), u1 = bfhi(q.x), u2 = bflo(q.y), u3 = bfhi(q.y);
        s0 += u0; s1 += u1; s2 += u2; s3 += u3;
        const float ic = 1.0f / (float)(t + 1 < W ? t + 1 : W);
        u32x2 o; o.x = pk2(s0 * ic - u0, s1 * ic - u1); o.y = pk2(s2 * ic - u2, s3 * ic - u3);
        *(u32x2*)(P + (size_t)t * DM) = o;
        s0 -= bflo(r[j].x); s1 -= bfhi(r[j].x); s2 -= bflo(r[j].y); s3 -= bfhi(r[j].y);
        if (t >= SEQ - 15) *(f32x4*)(OPp + (size_t)(t - (SEQ - 15)) * DM) = (f32x4){u0, u1, u2, u3}; }
}
__device__ __forceinline__ void pool_prompt_item(const Ctx& F, int item, const bf16_t* proj, bf16_t* pooled, float* out) {
    const int b = item >> 7, t0 = (item & 127) * 16, c0 = 4 * F.tid, g = F.tid >> 7;
    const bf16_t* U = proj + (size_t)b * SEQ * DPROJP + PC_POOL + c0;
    bf16_t* P = pooled + (size_t)b * SEQ * DM + c0;
    float* OPp = out + O_PPOOL + (size_t)b * 15 * DM + c0;
    if (g == 0) pool_prompt_run<2>(U, P, OPp, t0); else if (g == 1) pool_prompt_run<4>(U, P, OPp, t0); else if (g == 2) pool_prompt_run<8>(U, P, OPp, t0); else pool_prompt_run<16>(U, P, OPp, t0);
}
template <int W> __device__ __forceinline__ void pool_sample_run(const bf16_t* U, const float* SPp, bf16_t* P, float* OP) {
    f32x4 f[19];
#pragma unroll
    for (int r = 0; r < 15; ++r) f[r] = *(const f32x4*)(SPp + (size_t)r * DM);
#pragma unroll
    for (int t = 0; t < 4; ++t) { const u32x2 q = *(const u32x2*)(U + (size_t)t * DPROJP); f[15 + t] = (f32x4){bflo(q.x), bfhi(q.x), bflo(q.y), bfhi(q.y)}; }
    f32x4 s = (f32x4){0.f, 0.f, 0.f, 0.f};
#pragma unroll
    for (int r = 15 - W + 1; r < 15; ++r) s += f[r];
#pragma unroll
    for (int t = 0; t < 4; ++t) { s += f[15 + t]; const f32x4 pv = s * (1.0f / (float)W) - f[15 + t];
        u32x2 o; o.x = pk2(pv.x, pv.y); o.y = pk2(pv.z, pv.w); *(u32x2*)(P + (size_t)t * DM) = o; s -= f[15 + t - W + 1]; }
#pragma unroll
    for (int r = 4; r < 19; ++r) *(f32x4*)(OP + (size_t)(r - 4) * DM) = f[r];
}
__device__ __forceinline__ void pool_sample_item(const Ctx& F, int bb, const bf16_t* proj, const float* spool, bf16_t* pooled, float* out) {
    const int c0 = 4 * F.tid, g = F.tid >> 7;
    const bf16_t* U = proj + (size_t)(MP + 4 * bb) * DPROJP + PC_POOL + c0;
    const float* SPp = spool + (size_t)bb * 15 * DM + c0;
    bf16_t* P = pooled + (size_t)(MP + 4 * bb) * DM + c0;
    float* OP = out + O_SPOOL + (size_t)bb * 15 * DM + c0;
    if (g == 0) pool_sample_run<2>(U, SPp, P, OP); else if (g == 1) pool_sample_run<4>(U, SPp, P, OP); else if (g == 2) pool_sample_run<8>(U, SPp, P, OP); else pool_sample_run<16>(U, SPp, P, OP);
}

__device__ __forceinline__ void prepass_phase(const Ctx& F, const Args& a) {
    unsigned char* ws = a.ws;
    const bf16_t* proj = (const bf16_t*)(ws + WS_PROJ); bf16_t* xact = (bf16_t*)(ws + WS_XACT); float* dtv = (float*)(ws + WS_DTRAW); bf16_t* pooled = (bf16_t*)(ws + WS_POOLED);
    const float* cwt = a.in[16]; const float* cbs = a.in[17];
    const int gtid = F.bid * 512 + F.tid, NT = F.G * 512;
    for (int id = gtid; id < NB * 128 * 768; id += NT) {
        const int oc = id % 768, run = id / 768, b = run >> 7, t0 = (run & 127) * 16, ch = oc * 8;
        const bf16_t* src = proj + (size_t)(b * SEQ + t0) * DPROJP + PC_XBC + ch;
        u32x4 r[19];
#pragma unroll
        for (int i = 0; i < 19; ++i) r[i] = (t0 - 3 + i >= 0) ? *(const u32x4*)(src + (ptrdiff_t)(i - 3) * DPROJP) : (u32x4){0u, 0u, 0u, 0u};
        f32x4 w[4][2], bs[2];
#pragma unroll
        for (int k = 0; k < 4; ++k) { w[k][0] = *(const f32x4*)(cwt + (size_t)k * CONVD + ch); w[k][1] = *(const f32x4*)(cwt + (size_t)k * CONVD + ch + 4); }
        bs[0] = *(const f32x4*)(cbs + ch); bs[1] = *(const f32x4*)(cbs + ch + 4);
        bf16_t* dst = xact + (size_t)(b * SEQ + t0) * CONVD + ch;
#pragma unroll
        for (int j = 0; j < 16; ++j) { f32x4 o0 = bs[0], o1 = bs[1];
#pragma unroll
            for (int k = 0; k < 4; ++k) { const u32x4 q = r[j + k];
                o0 += w[k][0] * (f32x4){bflo(q.x), bfhi(q.x), bflo(q.y), bfhi(q.y)}; o1 += w[k][1] * (f32x4){bflo(q.z), bfhi(q.z), bflo(q.w), bfhi(q.w)}; }
            u32x4 pw; pw.x = pk2(siluf_(o0.x), siluf_(o0.y)); pw.y = pk2(siluf_(o0.z), siluf_(o0.w)); pw.z = pk2(siluf_(o1.x), siluf_(o1.y)); pw.w = pk2(siluf_(o1.z), siluf_(o1.w));
            *(u32x4*)(dst + (size_t)j * CONVD) = pw; }
        if (t0 == SEQ - 16) {
#pragma unroll
            for (int jj = 0; jj < 3; ++jj) { const u32x4 q = r[16 + jj]; float* o = a.out + O_PCONV + ((size_t)b * 3 + jj) * CONVD + ch;
                *(f32x4*)o = (f32x4){bflo(q.x), bfhi(q.x), bflo(q.y), bfhi(q.y)}; *(f32x4*)(o + 4) = (f32x4){bflo(q.z), bfhi(q.z), bflo(q.w), bfhi(q.w)}; } }
    }
    for (int id = gtid; id < DB * 768; id += NT) {
        const int oc = id % 768, bb = id / 768, ch = oc * 8;
        f32x4 f[7][2];
#pragma unroll
        for (int r = 0; r < 3; ++r) { const float* sp = a.in[5] + ((size_t)bb * 3 + r) * CONVD + ch; f[r][0] = *(const f32x4*)sp; f[r][1] = *(const f32x4*)(sp + 4); }
#pragma unroll
        for (int r = 0; r < 4; ++r) { const u32x4 q = *(const u32x4*)(proj + (size_t)(MP + 4 * bb + r) * DPROJP + PC_XBC + ch);
            f[3 + r][0] = (f32x4){bflo(q.x), bfhi(q.x), bflo(q.y), bfhi(q.y)}; f[3 + r][1] = (f32x4){bflo(q.z), bfhi(q.z), bflo(q.w), bfhi(q.w)}; }
        f32x4 w[4][2], bs[2];
#pragma unroll
        for (int k = 0; k < 4; ++k) { w[k][0] = *(const f32x4*)(cwt + (size_t)k * CONVD + ch); w[k][1] = *(const f32x4*)(cwt + (size_t)k * CONVD + ch + 4); }
        bs[0] = *(const f32x4*)(cbs + ch); bs[1] = *(const f32x4*)(cbs + ch + 4);
#pragma unroll
        for (int t = 0; t < 4; ++t) { f32x4 o0 = bs[0], o1 = bs[1];
#pragma unroll
            for (int k = 0; k < 4; ++k) { o0 += w[k][0] * f[t + k][0]; o1 += w[k][1] * f[t + k][1]; }
            u32x4 pw; pw.x = pk2(siluf_(o0.x), siluf_(o0.y)); pw.y = pk2(siluf_(o0.z), siluf_(o0.w)); pw.z = pk2(siluf_(o1.x), siluf_(o1.y)); pw.w = pk2(siluf_(o1.z), siluf_(o1.w));
            *(u32x4*)(xact + (size_t)(MP + 4 * bb + t) * CONVD + ch) = pw; }
#pragma unroll
        for (int jj = 0; jj < 3; ++jj) { float* o = a.out + O_SCONV + ((size_t)bb * 3 + jj) * CONVD + ch; *(f32x4*)o = f[4 + jj][0]; *(f32x4*)(o + 4) = f[4 + jj][1]; }
    }
    for (int id = gtid; id < MT * 64 / 4; id += NT) { f32x4 v = *(const f32x4*)(dtv + (size_t)id * 4); const f32x4 bb4 = *(const f32x4*)(a.in[18] + (id & 15) * 4);
        v.x = softplusf_(v.x + bb4.x); v.y = softplusf_(v.y + bb4.y); v.z = softplusf_(v.z + bb4.z); v.w = softplusf_(v.w + bb4.w); *(f32x4*)(dtv + (size_t)id * 4) = v; }
    for (int it = F.bid; it < NB * 128; it += F.G) pool_prompt_item(F, it, proj, pooled, a.out);
    for (int it = F.bid; it < DB; it += F.G) pool_sample_item(F, it, proj, a.in[6], pooled, a.out);
}

__device__ __forceinline__ void scan_prompt_item(const Ctx& F, int b, int h, const Args& a, const bf16_t* proj, const bf16_t* xact, const float* dtv, bf16_t* ygated, float* ssq) {
    LAS unsigned char* L = F.lds;
    const int tid = F.tid, w = F.wave, lane = F.lane, fr = lane & 15, fq = lane >> 4, g = h >> 3;
    const float aneg = -__expf(a.in[19][h]), Dk = a.in[20][h];
    LAS float* sS = (LAS float*)(L + SC_S); LAS float* sDT = (LAS float*)(L + SC_DT); LAS float* sW = (LAS float*)(L + SC_W); LAS float* sE = (LAS float*)(L + SC_E);
    __syncthreads();
    for (int i = tid; i < 17408 / 4; i += 512) ((LAS unsigned*)(L + SC_HB))[i] = 0u;
    f32x4 hreg[4];
#pragma unroll
    for (int pt = 0; pt < 4; ++pt) hreg[pt] = (f32x4){0.f, 0.f, 0.f, 0.f};
    u32x4 px[2], pb[4], pc[4]; float pd0 = 0.f, pd1 = 0.f;
#define SCAN_LOAD(cc) do { const int m0_ = b * SEQ + (cc) * 128; \
        _Pragma("unroll") for (int i = 0; i < 2; ++i) { const int v = tid + 512 * i; px[i] = *(const u32x4*)(xact + (size_t)(m0_ + (v >> 3)) * CONVD + h * 64 + 8 * (v & 7)); } \
        _Pragma("unroll") for (int i = 0; i < 4; ++i) { const int v = tid + 512 * i; pb[i] = *(const u32x4*)(xact + (size_t)(m0_ + (v >> 4)) * CONVD + DIN + g * 128 + 8 * (v & 15)); } \
        _Pragma("unroll") for (int ks = 0; ks < 4; ++ks) pc[ks] = *(const u32x4*)(xact + (size_t)(m0_ + 16 * w + fr) * CONVD + DIN + 1024 + g * 128 + 32 * ks + 8 * fq); \
        if (w == 0) { pd0 = dtv[(size_t)(m0_ + 2 * lane) * 64 + h]; pd1 = dtv[(size_t)(m0_ + 2 * lane + 1) * 64 + h]; } } while (0)
    SCAN_LOAD(0);
    for (int c = 0; c < 16; ++c) {
        const int m0 = b * SEQ + c * 128;
        __syncthreads();
        u32x2 zr[4];
#pragma unroll
        for (int pt = 0; pt < 4; ++pt) zr[pt] = *(const u32x2*)(proj + (size_t)(m0 + 16 * w + fr) * DPROJP + PC_Z + h * 64 + 16 * pt + 4 * fq);
#pragma unroll
        for (int i = 0; i < 2; ++i) { const int v = tid + 512 * i, pg = v & 7, s_ = v >> 3; const unsigned q[4] = {px[i].x, px[i].y, px[i].z, px[i].w};
#pragma unroll
            for (int e = 0; e < 4; ++e) { *(LAS bf16_t*)(L + SC_XT + (8 * pg + 2 * e) * SP + s_ * 2) = (bf16_t)(q[e] & 0xffffu); *(LAS bf16_t*)(L + SC_XT + (8 * pg + 2 * e + 1) * SP + s_ * 2) = (bf16_t)(q[e] >> 16); } }
#pragma unroll
        for (int i = 0; i < 4; ++i) { const int v = tid + 512 * i; *(LAS u32x4*)(L + SC_BN + (v >> 4) * SP + (v & 15) * 16) = pb[i]; }
        bf16x8 Cf[4];
#pragma unroll
        for (int ks = 0; ks < 4; ++ks) Cf[ks] = __builtin_bit_cast(bf16x8, pc[ks]);
        if (w == 0) {
            const float d0 = pd0, d1 = pd1, l0 = d0 * aneg, l1 = d1 * aneg; float inc = l0 + l1;
#pragma unroll
            for (int o = 1; o < 64; o <<= 1) { const float v = __shfl_up(inc, o); if (lane >= o) inc += v; }
            const float s1 = inc, s0 = inc - l1, slast = __shfl(inc, 63);
            sS[2 * lane] = s0; sS[2 * lane + 1] = s1; sDT[2 * lane] = d0; sDT[2 * lane + 1] = d1;
            sW[2 * lane] = __expf(slast - s0) * d0; sW[2 * lane + 1] = __expf(slast - s1) * d1; sE[2 * lane] = __expf(s0); sE[2 * lane + 1] = __expf(s1);
        }
        if (c < 15) SCAN_LOAD(c + 1);
        __syncthreads();
        const float st = sS[16 * w + fr];
        for (int j = 0; j <= w; ++j) {
            f32x4 d = (f32x4){0.f, 0.f, 0.f, 0.f};
#pragma unroll
            for (int ks = 0; ks < 4; ++ks) { const bf16x8 bfr = *(const LAS bf16x8*)(L + SC_BN + (16 * j + fr) * SP + (32 * ks + 8 * fq) * 2); d = __builtin_amdgcn_mfma_f32_16x16x32_bf16(bfr, Cf[ks], d, 0, 0, 0); }
            MFMA_SETTLE1(d);
            const f32x4 ss4 = *(const LAS f32x4*)(sS + 16 * j + 4 * fq), dt4 = *(const LAS f32x4*)(sDT + 16 * j + 4 * fq);
            float wv[4];
#pragma unroll
            for (int v = 0; v < 4; ++v) { const int si = 16 * j + 4 * fq + v; wv[v] = (si <= 16 * w + fr) ? d[v] * __expf(st - ss4[v]) * dt4[v] : 0.f; }
            u32x2 pw; pw.x = pk2(wv[0], wv[1]); pw.y = pk2(wv[2], wv[3]);
            *(LAS u32x2*)(L + SC_WM + (16 * w + fr) * SP + (16 * j + 4 * fq) * 2) = pw;
        }
        if ((w & 1) == 0) *(LAS u32x2*)(L + SC_WM + (16 * w + fr) * SP + (16 * (w + 1) + 4 * fq) * 2) = (u32x2){0u, 0u};
        LDS_WAIT(); asm volatile("" ::: "memory");
        f32x4 accO[4], accD[4];
        const int hbo = SC_HB + (c & 1) * 17408;
#pragma unroll
        for (int pt = 0; pt < 4; ++pt) { accO[pt] = (f32x4){0.f, 0.f, 0.f, 0.f}; accD[pt] = (f32x4){0.f, 0.f, 0.f, 0.f};
#pragma unroll
            for (int ks = 0; ks < 4; ++ks) { const bf16x8 X = *(const LAS bf16x8*)(L + hbo + (16 * pt + fr) * SP + (32 * ks + 8 * fq) * 2); accO[pt] = __builtin_amdgcn_mfma_f32_16x16x32_bf16(X, Cf[ks], accO[pt], 0, 0, 0); } }
        const int nks = (w >> 1) + 1;
        for (int ks = 0; ks < nks; ++ks) { const bf16x8 Y = *(const LAS bf16x8*)(L + SC_WM + (16 * w + fr) * SP + (32 * ks + 8 * fq) * 2);
#pragma unroll
            for (int pt = 0; pt < 4; ++pt) { const bf16x8 X = *(const LAS bf16x8*)(L + SC_XT + (16 * pt + fr) * SP + (32 * ks + 8 * fq) * 2); accD[pt] = __builtin_amdgcn_mfma_f32_16x16x32_bf16(X, Y, accD[pt], 0, 0, 0); } }
        MFMA_SETTLE4(accO[0], accO[1], accO[2], accO[3]);
        {
            const float et = sE[16 * w + fr]; const int mrow = m0 + 16 * w + fr; float q = 0.f;
#pragma unroll
            for (int pt = 0; pt < 4; ++pt) { const int p0 = 16 * pt + 4 * fq;
                const float zv[4] = {bflo(zr[pt].x), bfhi(zr[pt].x), bflo(zr[pt].y), bfhi(zr[pt].y)}; float y[4];
#pragma unroll
                for (int v = 0; v < 4; ++v) { const float xv = bf1(*(const LAS bf16_t*)(L + SC_XT + (p0 + v) * SP + (16 * w + fr) * 2));
                    y[v] = (accO[pt][v] * et + accD[pt][v] + Dk * xv) * zv[v]; q += y[v] * y[v]; }
                u32x2 pw; pw.x = pk2(y[0], y[1]); pw.y = pk2(y[2], y[3]);
                *(u32x2*)(ygated + (size_t)mrow * DIN + h * 64 + p0) = pw; }
            q += __shfl_xor(q, 16); q += __shfl_xor(q, 32);
            if (fq == 0) atomicAdd(ssq + (size_t)mrow * 8 + g, q);
        }
        {
            const float es = sE[127];
#pragma unroll
            for (int pt = 0; pt < 4; ++pt) hreg[pt] = hreg[pt] * es;
#pragma unroll
            for (int ks = 0; ks < 4; ++ks) {
                const f32x4 w0 = *(const LAS f32x4*)(sW + 32 * ks + 8 * fq), w1 = *(const LAS f32x4*)(sW + 32 * ks + 8 * fq + 4);
                const float wsv[8] = {w0.x, w0.y, w0.z, w0.w, w1.x, w1.y, w1.z, w1.w};
                unsigned bw[4];
#pragma unroll
                for (int jj = 0; jj < 4; ++jj) { const float lo = bf1(*(const LAS bf16_t*)(L + SC_BN + (32 * ks + 8 * fq + 2 * jj) * SP + (16 * w + fr) * 2)), hi = bf1(*(const LAS bf16_t*)(L + SC_BN + (32 * ks + 8 * fq + 2 * jj + 1) * SP + (16 * w + fr) * 2));
                    bw[jj] = pk2(lo * wsv[2 * jj], hi * wsv[2 * jj + 1]); }
                const bf16x8 Y = __builtin_bit_cast(bf16x8, (u32x4){bw[0], bw[1], bw[2], bw[3]});
#pragma unroll
                for (int pt = 0; pt < 4; ++pt) { const bf16x8 X = *(const LAS bf16x8*)(L + SC_XT + (16 * pt + fr) * SP + (32 * ks + 8 * fq) * 2); hreg[pt] = __builtin_amdgcn_mfma_f32_16x16x32_bf16(X, Y, hreg[pt], 0, 0, 0); }
            }
            MFMA_SETTLE4(hreg[0], hreg[1], hreg[2], hreg[3]);
            const int hbn = SC_HB + ((c + 1) & 1) * 17408;
#pragma unroll
            for (int pt = 0; pt < 4; ++pt)
#pragma unroll
                for (int v = 0; v < 4; ++v) *(LAS bf16_t*)(L + hbn + (16 * pt + 4 * fq + v) * SP + (16 * w + fr) * 2) = (bf16_t)f2bf(hreg[pt][v]);
        }
    }
#undef SCAN_LOAD
    float* hs = a.out + O_PSSM + (size_t)(b * NH + h) * HD * DST;
#pragma unroll
    for (int pt = 0; pt < 4; ++pt)
#pragma unroll
        for (int v = 0; v < 4; ++v) hs[(size_t)(16 * pt + 4 * fq + v) * DST + 16 * w + fr] = hreg[pt][v];
    __syncthreads();
}

__device__ __forceinline__ void scan_sample_item(const Ctx& F, int item, const Args& a, const bf16_t* proj, const bf16_t* xact, const float* dtv, bf16_t* ygated, float* ssq, LAS float* wl) {
    const int bb = item >> 6, h = item & 63, g = h >> 3, lane = F.lane;
    const int mb = MP + 4 * bb;
    const float aneg = -__expf(a.in[19][h]), Dk = a.in[20][h];
    float dt[4], sc[4], xv[4], Bv[4][2], Cv[4][2];
    { float run = 0.f;
#pragma unroll
      for (int t = 0; t < 4; ++t) { dt[t] = dtv[(size_t)(mb + t) * 64 + h]; run += dt[t] * aneg; sc[t] = run;
          const bf16_t* xr = xact + (size_t)(mb + t) * CONVD;
          xv[t] = bf1(xr[h * 64 + lane]);
          const unsigned qb = *(const unsigned*)(xr + DIN + g * 128 + 2 * lane), qc = *(const unsigned*)(xr + DIN + 1024 + g * 128 + 2 * lane);
          Bv[t][0] = bflo(qb); Bv[t][1] = bfhi(qb); Cv[t][0] = bflo(qc); Cv[t][1] = bfhi(qc); } }
    float yd[4];
#pragma unroll
    for (int t = 0; t < 4; ++t) { yd[t] = 0.f;
#pragma unroll
        for (int s = 0; s <= t; ++s) { const float gts = wave_sum(Cv[t][0] * Bv[s][0] + Cv[t][1] * Bv[s][1]); yd[t] += gts * __expf(sc[t] - sc[s]) * dt[s] * xv[s]; } }
    LAS float* xsl = wl; LAS float* yol = wl + 256;
    { f32x4 q; q.x = __expf(sc[3] - sc[0]) * dt[0] * xv[0]; q.y = __expf(sc[3] - sc[1]) * dt[1] * xv[1]; q.z = __expf(sc[3] - sc[2]) * dt[2] * xv[2]; q.w = dt[3] * xv[3];
      *(LAS f32x4*)(xsl + 4 * lane) = q; }
    LDS_WAIT(); asm volatile("" ::: "memory");
    const float e3 = __expf(sc[3]);
    const float* h0 = a.in[4] + (size_t)(bb * NH + h) * HD * DST + 2 * lane;
    float* h1 = a.out + O_SSSM + (size_t)(bb * NH + h) * HD * DST + 2 * lane;
    const bool b5 = (lane & 32) != 0, b4 = (lane & 16) != 0;
    for (int pb = 0; pb < 64; pb += 16) {
        f32x2 hvb[16];
#pragma unroll
        for (int k = 0; k < 16; ++k) hvb[k] = __builtin_nontemporal_load((const f32x2*)(h0 + (size_t)(pb + k) * DST));
#pragma unroll
        for (int k = 0; k < 16; ++k) { const int p = pb + k; const f32x2 hv = hvb[k];
        const f32x4 xs4 = *(const LAS f32x4*)(xsl + 4 * p);
        f32x2 hn; hn.x = e3 * hv.x + xs4.x * Bv[0][0] + xs4.y * Bv[1][0] + xs4.z * Bv[2][0] + xs4.w * Bv[3][0];
        hn.y = e3 * hv.y + xs4.x * Bv[0][1] + xs4.y * Bv[1][1] + xs4.z * Bv[2][1] + xs4.w * Bv[3][1];
        __builtin_nontemporal_store(hn, (f32x2*)(h1 + (size_t)p * DST));
        const float v0 = Cv[0][0] * hv.x + Cv[0][1] * hv.y, v1 = Cv[1][0] * hv.x + Cv[1][1] * hv.y, v2 = Cv[2][0] * hv.x + Cv[2][1] * hv.y, v3 = Cv[3][0] * hv.x + Cv[3][1] * hv.y;
        float k0 = b5 ? v2 : v0, k1 = b5 ? v3 : v1; const float q0 = b5 ? v0 : v2, q1 = b5 ? v1 : v3;
        k0 += __shfl_xor(q0, 32); k1 += __shfl_xor(q1, 32);
        float kk = b4 ? k1 : k0; const float qq = b4 ? k0 : k1;
        kk += __shfl_xor(qq, 16); kk += __shfl_xor(kk, 8); kk += __shfl_xor(kk, 4); kk += __shfl_xor(kk, 2); kk += __shfl_xor(kk, 1);
        if ((lane & 15) == 0) yol[(lane >> 4) * 64 + p] = kk;
        }
    }
    LDS_WAIT(); asm volatile("" ::: "memory");
#pragma unroll
    for (int t = 0; t < 4; ++t) {
        const float z = bf1(proj[(size_t)(mb + t) * DPROJP + PC_Z + h * 64 + lane]);
        const float y = (yol[t * 64 + lane] * __expf(sc[t]) + yd[t] + Dk * xv[t]) * z;
        ygated[(size_t)(mb + t) * DIN + h * 64 + lane] = (bf16_t)f2bf(y);
        const float q = wave_sum(y * y);
        if (lane == 0) atomicAdd(ssq + (size_t)(mb + t) * 8 + g, q);
    }
    LDS_WAIT(); asm volatile("" ::: "memory");
}

__device__ __forceinline__ void scan_phase(const Ctx& F, const Args& a) {
    unsigned char* ws = a.ws;
    const bf16_t* proj = (const bf16_t*)(ws + WS_PROJ); const bf16_t* xact = (const bf16_t*)(ws + WS_XACT); const float* dtv = (const float*)(ws + WS_DTRAW);
    bf16_t* ygated = (bf16_t*)(ws + WS_YSSM); float* ssq = (float*)(ws + WS_SSQ);
    const int vcu = (F.G % 8 == 0) ? (F.bid % 8) * (F.G / 8) + F.bid / 8 : F.bid;
    const bool sample_first = ((vcu >> 3) & 1) != 0;
    LAS float* wl = (LAS float*)(F.lds + F.wave * 4096);
    if (sample_first) { for (int it = F.bid * 8 + F.wave; it < DB * NH; it += F.G * 8) scan_sample_item(F, it, a, proj, xact, dtv, ygated, ssq, wl); __syncthreads(); }
    for (int it = vcu; it < NB * NH; it += F.G) scan_prompt_item(F, it >> 6, it & 63, a, proj, xact, dtv, ygated, ssq);
    __syncthreads();
    if (!sample_first) { for (int it = F.bid * 8 + F.wave; it < DB * NH; it += F.G * 8) scan_sample_item(F, it, a, proj, xact, dtv, ygated, ssq, wl); __syncthreads(); }
}

__device__ __forceinline__ void ssm_norm_rows(const Ctx& F, bf16_t* y, const float* ssq, const float* gamma) {
    const int gw = F.bid * 8 + F.wave, NGW = F.G * 8;
    for (int m = gw; m < MT; m += NGW) {
#pragma unroll
        for (int j = 0; j < 8; ++j) { const int c = 8 * F.lane + 512 * j;
            const float rinv = 1.0f / sqrtf(ssq[(size_t)m * 8 + j] * (1.0f / 512.0f) + EPS);
            u32x4* p = (u32x4*)(y + (size_t)m * DIN + c); const u32x4 r = *p;
            const f32x4 g0 = *(const f32x4*)(gamma + c), g1 = *(const f32x4*)(gamma + c + 4);
            u32x4 o; o.x = pk2(bflo(r.x) * rinv * g0.x, bfhi(r.x) * rinv * g0.y); o.y = pk2(bflo(r.y) * rinv * g0.z, bfhi(r.y) * rinv * g0.w);
            o.z = pk2(bflo(r.z) * rinv * g1.x, bfhi(r.z) * rinv * g1.y); o.w = pk2(bflo(r.w) * rinv * g1.z, bfhi(r.w) * rinv * g1.w);
            *p = o; }
    }
}

__device__ __forceinline__ void tail_tiles_merge(const Ctx& F, const float* partA, const float* partB, bf16_t* merged) {
    pg8::StaticOrder Sa; Sa.init(MT, DM, DM, F.G, F.bid, true); pg8::StaticOrder Sb; Sb.init(MT, DM, DIN, F.G, F.bid, true); if (Sa.S <= 1) return;
    for (int j = F.bid; j < Sa.tail * 8; j += F.G) { const int un = j >> 3, sub = j & 7; Unit u; Sa.decode(Sa.full + un, u);
        for (int i = F.tid; i < 32 * 64; i += 512) { const int lr = sub * 32 + (i >> 6), lc = (i & 63) * 4; f32x4 v = (f32x4){0.f, 0.f, 0.f, 0.f};
            if (Sa.S == 16 && Sb.S == 16) {
                const bf16_t* pa_ = (const bf16_t*)partA + (size_t)(un * 16) * 65536 + lr * 256 + lc; const bf16_t* pb_ = (const bf16_t*)partB + (size_t)(un * 16) * 65536 + lr * 256 + lc;
                u32x2 pw[32];
#pragma unroll
                for (int pc = 0; pc < 16; ++pc) { pw[pc] = *(const u32x2*)(pa_ + (size_t)pc * 65536); pw[16 + pc] = *(const u32x2*)(pb_ + (size_t)pc * 65536); }
#pragma unroll
                for (int pc = 0; pc < 32; ++pc) v += (f32x4){bflo(pw[pc].x), bfhi(pw[pc].x), bflo(pw[pc].y), bfhi(pw[pc].y)};
            } else {
            for (int pc = 0; pc < Sa.S; ++pc) { const u32x2 pw = *(const u32x2*)((const bf16_t*)partA + (size_t)(un * Sa.S + pc) * 65536 + lr * 256 + lc); v += (f32x4){bflo(pw.x), bfhi(pw.x), bflo(pw.y), bfhi(pw.y)}; }
            for (int pc = 0; pc < Sb.S; ++pc) { const u32x2 pw = *(const u32x2*)((const bf16_t*)partB + (size_t)(un * Sb.S + pc) * 65536 + lr * 256 + lc); v += (f32x4){bflo(pw.x), bfhi(pw.x), bflo(pw.y), bfhi(pw.y)}; }
            }
            u32x2 w; w.x = pk2(v.x, v.y); w.y = pk2(v.z, v.w); *(u32x2*)(merged + (size_t)(u.pm * 256 + lr) * DM + u.pn * 256 + lc) = w; } }
}
__device__ __forceinline__ int tail_map_build(const Ctx& F, int K, LAS int* tmap) {
    pg8::StaticOrder St; St.init(MT, DM, K, F.G, F.bid, true);
    __syncthreads();
    for (int i = F.tid; i < 34 * 8; i += 512) tmap[i] = -1;
    __syncthreads();
    if (St.S > 1 && F.tid < St.tail) { Unit u; St.decode(St.full + F.tid, u); tmap[u.pm * 8 + u.pn] = F.tid; }
    __syncthreads();
    return St.S;
}

#define XB_TMO      128
#define XB_XCNT(j)  (256  + 64 * (j))
#define XB_XSUB(j)  (1280 + 64 * (j))
#define XB_XGEN(j)  (2304 + 64 * (j))
#define XB_TOP      3328
#define XB_TOPGEN   3392
#define XCD_BAR_WORDS 3456
#define XB_SPIN_CAP (1u << 22)
__device__ __forceinline__ unsigned xb_ld(unsigned* p)              { return __hip_atomic_load(p, __ATOMIC_RELAXED, __HIP_MEMORY_SCOPE_AGENT); }
__device__ __forceinline__ unsigned xb_add(unsigned* p, unsigned v) { return __hip_atomic_fetch_add(p, v, __ATOMIC_RELAXED, __HIP_MEMORY_SCOPE_AGENT); }
__device__ __forceinline__ unsigned xb_xcc_id() { return (unsigned)__builtin_amdgcn_s_getreg((3 << 11) | 20) & 0xFu; }
#define XB_SPIN(cond, bar) do { unsigned _sp = 0; while (cond) { __builtin_amdgcn_s_sleep(1); \
    if ((++_sp & 255u) == 0u) { if (xb_ld(&(bar)[XB_TMO])) break; if (_sp > XB_SPIN_CAP) { atomicAdd(&(bar)[XB_TMO], 1u); break; } } } } while (0)
struct XcdBarrier { unsigned* bar; unsigned x; volatile LAS unsigned* st; };
__device__ __forceinline__ XcdBarrier xcd_barrier_post(unsigned* bar, volatile LAS unsigned* st) {
    XcdBarrier b; b.bar = bar; b.x = xb_xcc_id(); b.st = st;
    if (threadIdx.x == 0) (void)xb_add(&bar[XB_XCNT(b.x)], 1u);
    return b;
}
__device__ __forceinline__ void xcd_barrier_complete(unsigned* bar, unsigned x, unsigned& nloc, unsigned& nx) {
    const unsigned G = gridDim.x * gridDim.y * gridDim.z;
    unsigned sum, cnt, mine, sp = 0u;
    for (;;) {
        sum = 0u; cnt = 0u; mine = 0u;
#pragma unroll
        for (unsigned j = 0; j < 16; ++j) { const unsigned c = xb_ld(&bar[XB_XCNT(j)]); sum += c; cnt += (c > 0u) ? 1u : 0u; mine = (j == x) ? c : mine; }
        if (sum == G) break;
        __builtin_amdgcn_s_sleep(1);
        if ((++sp & 255u) == 0u) { if (xb_ld(&bar[XB_TMO])) break; if (sp > XB_SPIN_CAP) { atomicAdd(&bar[XB_TMO], 1u); break; } }
    }
    nloc = mine > 0u ? mine : 1u; nx = cnt > 0u ? cnt : 1u;
}
__device__ __forceinline__ void xcd_barrier(const XcdBarrier& b) {
    asm volatile("s_waitcnt vmcnt(0)" ::: "memory");
    __syncthreads();
    if (threadIdx.x == 0) {
        unsigned* bar = b.bar;
        __builtin_amdgcn_s_waitcnt(0);
        unsigned nloc = b.st[0], nx = b.st[1];
        if (nloc == 0u) { xcd_barrier_complete(bar, b.x, nloc, nx); b.st[0] = nloc; b.st[1] = nx; }
        const unsigned old = xb_add(&bar[XB_XSUB(b.x)], 1u);
        const unsigned gen = old / nloc;
        if (old + 1u == (gen + 1u) * nloc) {
            __builtin_amdgcn_fence(__ATOMIC_RELEASE, "agent");
            asm volatile("s_waitcnt vmcnt(0)" ::: "memory");
            const unsigned og = xb_add(&bar[XB_TOP], 1u);
            const unsigned tg = og / nx;
            if (og + 1u == (tg + 1u) * nx) xb_add(&bar[XB_TOPGEN], 1u);
            else XB_SPIN(xb_ld(&bar[XB_TOPGEN]) == tg, bar);
            __builtin_amdgcn_fence(__ATOMIC_ACQUIRE, "agent");
            xb_add(&bar[XB_XGEN(b.x)], 1u);
            asm volatile("s_waitcnt vmcnt(0)" ::: "memory");
        } else {
            XB_SPIN(xb_ld(&bar[XB_XGEN(b.x)]) == gen, bar);
            __builtin_amdgcn_fence(__ATOMIC_ACQUIRE, "agent");
            asm volatile("s_waitcnt vmcnt(0)" ::: "memory");
        }
    }
    __syncthreads();
}

constexpr int NPHASE = 18;
__global__ void __launch_bounds__(512, 2) fwd_megakernel(Args args) {
    extern __shared__ __attribute__((aligned(16))) unsigned char lds_raw[];
    Ctx F; F.lds = (LAS unsigned char*)lds_raw; F.tid = threadIdx.x; F.lane = F.tid & 63; F.wave = __builtin_amdgcn_readfirstlane(F.tid >> 6); F.G = gridDim.x; F.bid = blockIdx.x;
    unsigned char* ws = args.ws;
    const int lo = args.ph_lo, hi = args.ph_hi;
#define IN(k) (lo <= (k) && (k) < hi)
    { volatile LAS unsigned* st = (volatile LAS unsigned*)(F.lds + LDS_BYTES - 64); if (F.tid < 2) st[F.tid] = 0u; }
    __syncthreads();
    XcdBarrier xbar; xbar.bar = nullptr; xbar.x = 0; xbar.st = nullptr;
    if (args.coop) xbar = xcd_barrier_post((unsigned*)(ws + WS_CTL) + 4096, (volatile LAS unsigned*)(F.lds + LDS_BYTES - 64));
    if (args.coop == 2) cg::this_grid().sync();
#define SEAM(k) do { if (IN(k) && IN((k) + 1)) xcd_barrier(xbar); } while (0)
    float* mods = (float*)(ws + WS_MODS); bf16_t* act = (bf16_t*)(ws + WS_ACT); float* hbuf = (float*)(ws + WS_H); bf16_t* hmid = (bf16_t*)(ws + WS_HMID);
    bf16_t* proj = (bf16_t*)(ws + WS_PROJ); float* tmp = (float*)(ws + WS_TMP); bf16_t* merged = (bf16_t*)(ws + WS_ACT);
    pg8::StaticOrder S;
    LAS int* tmapL = (LAS int*)(F.lds + 140000);

    if (IN(0)) { p0_prologue(F, args, 0, 0, F.G); } SEAM(0);
    if (IN(1)) {
        pg8::Gemm g{(const bf16_t*)(ws + WS_AC), (const bf16_t*)(ws + WS_WADA), 256, NMOD, DM, 0, 0}; S.init(256, NMOD, DM, F.G, F.bid, false);
        EpiMods E{mods};
        constexpr int NQ = NMOD / 256;
        pg8::Gemm g2{(const bf16_t*)(ws + WS_WBP), (const bf16_t*)(ws + WS_WPOOL), DM, DM, 512, 2, (size_t)512 * 2, DM}; EpiPlain E2{(bf16_t*)(ws + WS_YPOOL)};
        if (F.G >= NQ + 64) {
            if (F.bid < NQ) { pg8::gemm_phase<EpiMods>(F.lds, g, S, E); __syncthreads(); pg8::StaticOrder S2; S2.init(DM, DM, 512, NQ, F.bid, false); pg8::gemm_phase<EpiPlain>(F.lds, g2, S2, E2); }
            else p0_prologue(F, args, 1, NQ, F.G - NQ);
        } else { pg8::gemm_phase<EpiMods>(F.lds, g, S, E); __syncthreads(); pg8::StaticOrder S2; S2.init(DM, DM, 512, F.G, F.bid, false); pg8::gemm_phase<EpiPlain>(F.lds, g2, S2, E2); __syncthreads(); p0_prologue(F, args, 1, 0, F.G); }
    } SEAM(1);
    if (IN(2)) { norm_mod_rows(F, args.in[0], args.in[1], args.in[9], mods, 0 * DM, 1 * DM, act, nullptr, nullptr, nullptr, 1, nullptr); } SEAM(2);
    if (IN(3)) {
        pg8::Gemm g{act, (const bf16_t*)(ws + WS_W13A), MT, 2 * DFF, DM, 0, 0}; S.init(MT, 2 * DFF, DM, F.G, F.bid, false);
        EpiSwiglu E{hmid}; pg8::gemm_phase<EpiSwiglu>(F.lds, g, S, E);
        if (S.tail > 0 && F.bid >= S.tail) { __syncthreads(); convert_range(F, args, P0_EARLY + (F.bid - S.tail) * 8 + F.wave, P0_DEFER_A, (F.G - S.tail) * 8); }
        else if (S.tail == 0 && F.bid == 0) { __syncthreads(); convert_range(F, args, P0_EARLY + F.wave, P0_DEFER_A, 8); }
    } SEAM(3);
    if (IN(4)) {
        pg8::Gemm g{hmid, (const bf16_t*)(ws + WS_W2A), MT, DM, DFF, 0, 0}; S.init(MT, DM, DFF, F.G, F.bid, true);
        EpiResid E{hbuf, mods + 2 * DM, 0.5f, (float*)(ws + WS_TMP), args.in[0], args.in[1]}; pg8::gemm_phase<EpiResid>(F.lds, g, S, E);
    } SEAM(4);
    if (IN(5)) { const int Sp = tail_map_build(F, DFF, tmapL); norm_mod_rows(F, hbuf, hbuf + (size_t)MP * DM, args.in[12], mods, 3 * DM, 4 * DM, act, args.in[0], args.in[1], (const float*)(ws + WS_TMP), Sp, tmapL); } SEAM(5);
    if (IN(6)) {
        pg8::Gemm g{act, (const bf16_t*)(ws + WS_WIN), MT, DPROJP, DM, 0, 0}; S.init(MT, DPROJP, DM, F.G, F.bid, false);
        EpiProj E{proj, (float*)(ws + WS_DTRAW)}; pg8::gemm_phase<EpiProj>(F.lds, g, S, E);
        if (S.tail > 0 && F.bid >= S.tail) { __syncthreads(); convert_range(F, args, P0_DEFER_A + (F.bid - S.tail) * 8 + F.wave, P0_NITEMS, (F.G - S.tail) * 8); }
        else if (S.tail == 0 && F.bid == 0) { __syncthreads(); convert_range(F, args, P0_DEFER_A + F.wave, P0_NITEMS, 8); }
    } SEAM(6);
    if (IN(7)) { prepass_phase(F, args); } SEAM(7);
    if (IN(8)) { scan_phase(F, args); } SEAM(8);
    if (IN(9)) {
        ssm_norm_rows(F, (bf16_t*)(ws + WS_YSSM), (const float*)(ws + WS_SSQ), args.in[21]);
    }
    if (IN(10)) {
        pg8::Gemm g{(const bf16_t*)(ws + WS_POOLED), (const bf16_t*)(ws + WS_YPOOL), MT, DM, DM, 0, 0}; S.init(MT, DM, DM, F.G, F.bid, true);
        EpiGate<false> E{proj, PC_GP, tmp, nullptr, (float*)(ws + WS_W13A)}; pg8::gemm_phase<EpiGate<false>>(F.lds, g, S, E);
    } SEAM(10);
    if (IN(11)) {
        pg8::Gemm g{(const bf16_t*)(ws + WS_YSSM), (const bf16_t*)(ws + WS_WBS), MT, DM, DIN, 0, 0}; S.init(MT, DM, DIN, F.G, F.bid, true);
        EpiGate<true> E{proj, PC_GS, tmp, merged, (float*)(ws + WS_WIN)}; pg8::gemm_phase<EpiGate<true>>(F.lds, g, S, E);
    } SEAM(11);
    if (IN(12)) { tail_tiles_merge(F, (const float*)(ws + WS_W13A), (const float*)(ws + WS_WIN), merged); } SEAM(12);
    if (IN(13)) {
        pg8::Gemm g{merged, (const bf16_t*)(ws + WS_WOUT), MT, DM, DM, 0, 0}; S.init(MT, DM, DM, F.G, F.bid, true);
        EpiResid E{hbuf, mods + 5 * DM, 1.0f, (float*)(ws + WS_W13A), nullptr, nullptr}; pg8::gemm_phase<EpiResid>(F.lds, g, S, E);
    } SEAM(13);
    if (IN(14)) { const int Sp = tail_map_build(F, DM, tmapL); norm_mod_rows(F, hbuf, hbuf + (size_t)MP * DM, args.in[25], mods, 6 * DM, 7 * DM, act, nullptr, nullptr, (const float*)(ws + WS_W13A), Sp, tmapL); } SEAM(14);
    if (IN(15)) {
        pg8::Gemm g{act, (const bf16_t*)(ws + WS_W13B), MT, 2 * DFF, DM, 0, 0}; S.init(MT, 2 * DFF, DM, F.G, F.bid, false);
        EpiSwiglu E{hmid}; pg8::gemm_phase<EpiSwiglu>(F.lds, g, S, E);
    } SEAM(15);
    if (IN(16)) {
        pg8::Gemm g{hmid, (const bf16_t*)(ws + WS_W2B), MT, DM, DFF, 0, 0}; S.init(MT, DM, DFF, F.G, F.bid, true);
        EpiResid E{hbuf, mods + 8 * DM, 0.5f, (float*)(ws + WS_W13A), nullptr, nullptr}; pg8::gemm_phase<EpiResid>(F.lds, g, S, E);
    } SEAM(16);
    if (IN(17)) { const int Sp = tail_map_build(F, DFF, tmapL); final_norm_rows(F, hbuf, args.in[28], args.out + O_Y, (const float*)(ws + WS_W13A), Sp, tmapL); }
#undef IN
#undef SEAM
}

extern "C" void kernel_launch(void* const* d_in, const int* in_sizes, int n_in, void* d_out, int out_size, void* d_ws, size_t ws_size, hipStream_t stream) {
    static int grid = 0;
    if (grid == 0) {
        if (n_in != 29 || (size_t)out_size != O_END || ws_size < WS_END) { fprintf(stderr, "kernel_launch: unexpected shapes: n_in %d out %d ws %zu (need %zu)\n", n_in, out_size, ws_size, (size_t)WS_END); grid = -1; return; }
        int dev = 0, cus = 0, per_cu = 0;
        hipGetDevice(&dev); hipDeviceGetAttribute(&cus, hipDeviceAttributeMultiprocessorCount, dev);
        if (hipFuncSetAttribute((const void*)fwd_megakernel, hipFuncAttributeMaxDynamicSharedMemorySize, LDS_BYTES) != hipSuccess) { fprintf(stderr, "kernel_launch: hipFuncSetAttribute failed\n"); grid = -1; return; }
        if (hipOccupancyMaxActiveBlocksPerMultiprocessor(&per_cu, (const void*)fwd_megakernel, 512, LDS_BYTES) != hipSuccess || per_cu < 1) { fprintf(stderr, "kernel_launch: occupancy query says %d\n", per_cu); per_cu = 1; }
        (void)hipGetLastError();
        grid = cus;
    }
    if (grid < 0) return;
    hipMemsetAsync((char*)d_ws + WS_CTL, 0, CTL_ZERO_BYTES, stream);
    Args a{};
    for (int i = 0; i < 29; ++i) a.in[i] = (const float*)d_in[i];
    a.out = (float*)d_out; a.ws = (unsigned char*)d_ws;
#if MK_N_LAUNCHES == 1
    a.ph_lo = 0; a.ph_hi = NPHASE; a.coop = 1;
    void* kargs[] = {&a};
    hipError_t e = hipLaunchCooperativeKernel((const void*)fwd_megakernel, dim3(grid), dim3(512), kargs, LDS_BYTES, stream);
    if (e != hipSuccess) fprintf(stderr, "cooperative launch failed: %s (grid %d)\n", hipGetErrorString(e), grid);
#else
    for (int p = 0; p < NPHASE; ++p) { a.ph_lo = p; a.ph_hi = p + 1; a.coop = 0; hipLaunchKernelGGL(fwd_megakernel, dim3(grid), dim3(512), LDS_BYTES, stream, a); }
#endif
}
```

```cpp
#include <hip/hip_runtime.h>
#include <hip/hip_cooperative_groups.h>
#include <cstdio>
#include <cstdint>
namespace cg = cooperative_groups;

#ifndef MK_N_LAUNCHES
#define MK_N_LAUNCHES 1
#endif

#define LAS __attribute__((address_space(3)))
typedef unsigned short bf16_t;
typedef short bf16x8 __attribute__((ext_vector_type(8)));
typedef float f32x4 __attribute__((ext_vector_type(4)));
typedef float f32x2 __attribute__((ext_vector_type(2)));
typedef unsigned u32x4 __attribute__((ext_vector_type(4)));
typedef unsigned u32x2 __attribute__((ext_vector_type(2)));

constexpr int DM = 2048, NB = 4, SEQ = 2048, DB = 128, DS = 4;
constexpr int MP = NB * SEQ, MS = DB * DS, MT = MP + MS;
constexpr int DFF = 5632, DIN = 4096, NH = 64, HD = 64, DST = 128, NG = 8, CONVD = 6144;
constexpr int DPROJ = 16448, DPROJP = 16640;
constexpr int NMOD = 9 * DM;
constexpr int PC_POOL = 0, PC_Z = 2048, PC_XBC = 6144, PC_DT = 12288, PC_GP = 12352, PC_GS = 14400;
constexpr float EPS = 1e-6f;
constexpr size_t O_Y = 0, O_PSSM = 17825792, O_PCONV = 19922944, O_PPOOL = 19996672, O_SSSM = 20119552, O_SCONV = 87228416, O_SPOOL = 89587712, O_END = 93519872;
constexpr size_t MiB = 1u << 20;
constexpr size_t WS_CTL = 0, CTL_ZERO_BYTES = 1 * MiB, WS_SSQ = 512 * 1024;
constexpr size_t WS_W13A = 1 * MiB, WS_W2A = 45 * MiB, WS_WIN = 67 * MiB, WS_WPOOL = 132 * MiB, WS_WBP = 134 * MiB, WS_WBS = 142 * MiB, WS_WOUT = 158 * MiB,
                 WS_W13B = 166 * MiB, WS_W2B = 210 * MiB, WS_WADA = 232 * MiB, WS_TMP = 232 * MiB  , WS_AC = 304 * MiB, WS_MODS = 305 * MiB,
                 WS_ACT = 323 * MiB, WS_H = 357 * MiB, WS_DTRAW = 425 * MiB, WS_POOLED = 428 * MiB, WS_YPOOL = 462 * MiB, WS_YSSM = 496 * MiB, WS_PROJ = 564 * MiB,
                 WS_HMID = 564 * MiB  , WS_XACT = 841 * MiB  , WS_END = 943 * MiB;
constexpr int LDS_BYTES = 155648;

namespace pg8 {
constexpr int BM = 256, BK = 64, HALF = 128, HTB = HALF * BK * 2, STAGE_BYTES = 8 * HTB, NXCD = 8, WGM = 8;
__host__ __device__ __forceinline__ int lds_byte(int r, int c) { const int st = (r >> 4) * 2 + (c >> 5), rr = r & 15, cc = c & 31, ob = rr * 64 + cc * 2; return st * 1024 + (ob ^ (((ob >> 9) & 1) << 5)); }
__host__ __device__ __forceinline__ void stage_rc(int b, int& R, int& C) { const int st = b / 1024, sb = b % 1024, swz = sb ^ (((sb >> 9) & 1) << 5); R = (st >> 1) * 16 + swz / 64; C = (st & 1) * 32 + (swz % 64) / 2; }
__host__ __device__ __forceinline__ int perm32(int rho) { const int n = rho >> 4, i = rho & 15; return 8 * (i >> 2) + 4 * n + (i & 3); }

struct Unit { int pm, pn, kt0, nkt, atomic, slot; };
struct Gemm { const bf16_t* A; const bf16_t* Bt; int M, N, K; int grp_pn; size_t a_grp_bytes; int lda; };

struct StaticOrder {
    int nM, nN, nwg, G, c, nt, full, tail, S;
    __device__ __forceinline__ void init(int M, int N, int K, int G_, int c_, bool allow_split) {
        nM = M / BM; nN = N / BM; nwg = nM * nN; G = G_; c = c_; nt = K / BK;
        full = (nwg / G) * G; tail = nwg - full; S = (allow_split && tail > 0) ? G / tail : 1;
        if (S > nt / 2) S = nt / 2; if (S < 1) S = 1;
    }
    __device__ __forceinline__ void decode(int L, Unit& u) const {
        int wgid = L; { const int q = nwg / NXCD, r = nwg % NXCD, xcd = wgid % NXCD, off = wgid / NXCD; wgid = (xcd < r ? xcd * (q + 1) : r * (q + 1) + (xcd - r) * q) + off; }
        const int nig = WGM * nN, gid = wgid / nig, fm = gid * WGM, gsz = (nM - fm) < WGM ? (nM - fm) : WGM;
        u.pm = fm + ((wgid % nig) % gsz); u.pn = (wgid % nig) / gsz;
    }
    __device__ __forceinline__ bool next(int i, Unit& u) const {
        const long L = (long)i * G + c;
        if (L < full) { decode((int)L, u); u.kt0 = 0; u.nkt = nt; u.atomic = 0; u.slot = 0; return true; }
        if (L >= full + G) return false;
        const int j = (int)(L - full);
        if (S == 1) { if (j >= tail) return false; decode(full + j, u); u.kt0 = 0; u.nkt = nt; u.atomic = 0; u.slot = 0; return true; }
        const int un = j / S, pc = j % S; if (un >= tail) return false;
        decode(full + un, u); const int pairs = nt / 2, p0 = pc * pairs / S, p1 = (pc + 1) * pairs / S;
        u.kt0 = 2 * p0; u.nkt = 2 * (p1 - p0); u.atomic = 1; u.slot = j; return true;
    }
};

__device__ __forceinline__ unsigned cvt_pk_bf16(float lo, float hi) { unsigned r; asm volatile("v_cvt_pk_bf16_f32 %0, %1, %2" : "=v"(r) : "v"(lo), "v"(hi)); return r; }

template <class Epi, bool ALIGN_EPI = true>
__device__ __forceinline__ void gemm_phase(LAS unsigned char* lds, const Gemm g, const StaticOrder& S, const Epi& E) {
    int tid_ = threadIdx.x; asm volatile("" : "+v"(tid_));
    const int tid = tid_, wid = __builtin_amdgcn_readfirstlane(tid >> 6), lane = tid & 63, wr = wid >> 2, wc = wid & 3, fr = lane & 15, fq = lane >> 4;
    const int K = g.K;
    unsigned voffA[2], voffB[2];
#pragma unroll
    for (int i = 0; i < 2; ++i) { int R, C; stage_rc(tid * 16 + i * 8192, R, C); const int Rb = Epi::PERM ? ((R & ~31) + perm32(R & 31)) : R;
        voffA[i] = (unsigned)(R * (g.lda ? g.lda : K) + C) * 2u; voffB[i] = (unsigned)(Rb * K + C) * 2u; }
    const size_t kstep = (size_t)(BK * 2);
    const size_t hstep = (size_t)HALF * K * 2;
    const size_t tstep = 2 * hstep;
    const size_t hstepA = (size_t)HALF * (g.lda ? g.lda : K) * 2, tstepA = 2 * hstepA;
    const unsigned ldsw = (unsigned)wid * 1024u;
    const int aoff = lds_byte(wr * 64 + fr, fq * 8), boff = lds_byte(wc * 32 + fr, fq * 8);
#define PG8_SA(b, h) (((b) * 2 + (h)) * HTB)
#define PG8_SB(b, h) ((4 + (b) * 2 + (h)) * HTB)
#define PG8_STAGE(bufoff, gbase, voff) do { _Pragma("unroll") for (int _i = 0; _i < 2; ++_i) \
        __builtin_amdgcn_global_load_lds((const unsigned*)((const char*)(gbase) + (voff)[_i]), (LAS unsigned*)(lds + (bufoff) + ldsw + _i * 8192), 16, 0, 0); } while (0)
#define PG8_LDA(dst, b, h) do { _Pragma("unroll") for (int m = 0; m < 4; ++m) _Pragma("unroll") for (int k = 0; k < 2; ++k) dst[m][k] = *(const LAS bf16x8*)(lds + PG8_SA(b, h) + aoff + m * 2048 + k * 1024); } while (0)
#define PG8_LDB(dst, b, h) do { _Pragma("unroll") for (int n = 0; n < 2; ++n) _Pragma("unroll") for (int k = 0; k < 2; ++k) dst[n][k] = *(const LAS bf16x8*)(lds + PG8_SB(b, h) + boff + n * 2048 + k * 1024); } while (0)
#define PG8_MMA(ai, bj, At, Bt) do { __builtin_amdgcn_s_setprio(1); _Pragma("unroll") for (int m = 0; m < 4; ++m) _Pragma("unroll") for (int n = 0; n < 2; ++n) _Pragma("unroll") for (int k = 0; k < 2; ++k) \
        acc[ai][bj][m][n] = __builtin_amdgcn_mfma_f32_16x16x32_bf16(Bt[n][k], At[m][k], acc[ai][bj][m][n], 0, 0, 0); __builtin_amdgcn_s_setprio(0); } while (0)
#define PG8_WAIT_V(n) asm volatile("s_waitcnt vmcnt(" #n ")" ::: "memory")
#define PG8_WAIT_L(n) asm volatile("s_waitcnt lgkmcnt(" #n ")" ::: "memory")
#define PG8_BAR __builtin_amdgcn_s_barrier()
#define PG8_SCHED __builtin_amdgcn_sched_barrier(0)
#define PG8_ABASE(u) ((const char*)g.A + (size_t)(u).pm * tstepA + (size_t)(u).kt0 * kstep + (g.grp_pn ? (size_t)((u).pn / g.grp_pn) * g.a_grp_bytes : (size_t)0))
#define PG8_BBASE(u) ((const char*)g.Bt + (size_t)(u).pn * tstep + (size_t)(u).kt0 * kstep)
    Unit cur, nxt; int ui = 0;
    if (!S.next(0, cur)) return;
    f32x4 acc[2][2][4][2];
#pragma unroll
    for (int a = 0; a < 2; ++a)
#pragma unroll
        for (int b = 0; b < 2; ++b)
#pragma unroll
            for (int m = 0; m < 4; ++m)
#pragma unroll
                for (int n = 0; n < 2; ++n) acc[a][b][m][n] = (f32x4){0.f, 0.f, 0.f, 0.f};
    bf16x8 At[4][2], B0[2][2], B1[2][2];
    const char* cA = PG8_ABASE(cur); const char* cB = PG8_BBASE(cur); int nt = cur.nkt;
    PG8_STAGE(PG8_SB(0, 0), cB, voffB); PG8_STAGE(PG8_SB(0, 1), cB + hstep, voffB); PG8_STAGE(PG8_SA(0, 0), cA, voffA); PG8_STAGE(PG8_SA(0, 1), cA + hstepA, voffA);
    if (wr == 1) PG8_BAR;
    PG8_WAIT_V(2); PG8_BAR;
    PG8_STAGE(PG8_SB(1, 0), cB + kstep, voffB); PG8_STAGE(PG8_SA(1, 0), cA + kstep, voffA); PG8_STAGE(PG8_SB(1, 1), cB + hstep + kstep, voffB);
    PG8_WAIT_V(6); PG8_BAR;
    for (;;) {
        const bool has_next = S.next(ui + 1, nxt);
        const char* nA = has_next ? PG8_ABASE(nxt) : cA; const char* nB = has_next ? PG8_BBASE(nxt) : cB;
        for (int t = 0; t < nt; t += 2) {
            const bool last = (t == nt - 2);
            const char* a1 = cA + (size_t)(t + 1) * kstep;
            const char* a2 = last ? nA : cA + (size_t)(t + 2) * kstep; const char* b2 = last ? nB : cB + (size_t)(t + 2) * kstep;
            const char* a3 = a2 + kstep; const char* b3 = b2 + kstep;
            PG8_LDB(B0, 0, 0); PG8_LDB(B1, 0, 1); PG8_SCHED; PG8_LDA(At, 0, 0); PG8_STAGE(PG8_SA(1, 1), a1 + hstepA, voffA);
            PG8_WAIT_V(8); PG8_WAIT_L(0); PG8_BAR; PG8_MMA(0, 0, At, B0); PG8_MMA(0, 1, At, B1); PG8_BAR; PG8_SCHED;
            PG8_LDA(At, 0, 1); PG8_STAGE(PG8_SB(0, 0), b2, voffB); PG8_STAGE(PG8_SB(0, 1), b2 + hstep, voffB); PG8_STAGE(PG8_SA(0, 0), a2, voffA);
            PG8_WAIT_V(8); PG8_WAIT_L(0); PG8_BAR; PG8_MMA(1, 0, At, B0); PG8_MMA(1, 1, At, B1); PG8_BAR; PG8_SCHED;
            PG8_LDB(B0, 1, 0); PG8_LDB(B1, 1, 1); PG8_SCHED; PG8_LDA(At, 1, 0); PG8_STAGE(PG8_SA(0, 1), a2 + hstepA, voffA);
            PG8_WAIT_V(8); PG8_WAIT_L(0); PG8_BAR; PG8_MMA(0, 0, At, B0); PG8_MMA(0, 1, At, B1); PG8_BAR; PG8_SCHED;
            PG8_LDA(At, 1, 1); PG8_STAGE(PG8_SB(1, 0), b3, voffB); PG8_STAGE(PG8_SB(1, 1), b3 + hstep, voffB); PG8_STAGE(PG8_SA(1, 0), a3, voffA);
            PG8_WAIT_V(8); PG8_WAIT_L(0); PG8_BAR; PG8_MMA(1, 0, At, B0); PG8_MMA(1, 1, At, B1); PG8_BAR; PG8_SCHED;
        }
        if constexpr (ALIGN_EPI) { if (wr == 0) PG8_BAR; }
        __builtin_amdgcn_sched_barrier(0); asm volatile("s_nop 15\n\ts_nop 3"); __builtin_amdgcn_sched_barrier(0);
        E(acc, cur, wr, wc, fr, fq);
        if (!has_next) break;
#pragma unroll
        for (int a = 0; a < 2; ++a)
#pragma unroll
            for (int b = 0; b < 2; ++b)
#pragma unroll
                for (int m = 0; m < 4; ++m)
#pragma unroll
                    for (int n = 0; n < 2; ++n) acc[a][b][m][n] = (f32x4){0.f, 0.f, 0.f, 0.f};
        cur = nxt; cA = nA; cB = nB; nt = cur.nkt; ++ui;
        if constexpr (ALIGN_EPI) { if (wr == 1) PG8_BAR; }
    }
    PG8_WAIT_V(0);
    if constexpr (!ALIGN_EPI) { if (wr == 0) PG8_BAR; }
    PG8_BAR;
#undef PG8_SA
#undef PG8_SB
#undef PG8_STAGE
#undef PG8_LDA
#undef PG8_LDB
#undef PG8_MMA
#undef PG8_WAIT_V
#undef PG8_WAIT_L
#undef PG8_BAR
#undef PG8_SCHED
#undef PG8_ABASE
#undef PG8_BBASE
}
}

typedef __bf16 bf16x2_t __attribute__((ext_vector_type(2)));
__device__ __forceinline__ unsigned pk2(float lo, float hi) { const f32x2 v = {lo, hi}; const bf16x2_t b = __builtin_convertvector(v, bf16x2_t); return __builtin_bit_cast(unsigned, b); }
__device__ __forceinline__ unsigned f2bf(float f) { return pk2(f, f) & 0xffffu; }
__device__ __forceinline__ float bflo(unsigned w) { return __builtin_bit_cast(float, w << 16); }
__device__ __forceinline__ float bfhi(unsigned w) { return __builtin_bit_cast(float, w & 0xffff0000u); }
__device__ __forceinline__ float bf1(bf16_t v) { return __builtin_bit_cast(float, (unsigned)v << 16); }
__device__ __forceinline__ float sigmoidf_(float v) { return 1.0f / (1.0f + __expf(-v)); }
__device__ __forceinline__ float siluf_(float v) { return v / (1.0f + __expf(-v)); }
__device__ __forceinline__ float sigmoid_fast(float v) { return __builtin_amdgcn_rcpf(1.0f + __expf(-v)); }
__device__ __forceinline__ float silu_fast(float v) { return v * __builtin_amdgcn_rcpf(1.0f + __expf(-v)); }
__device__ __forceinline__ float softplusf_(float v) { return v > 20.f ? v : log1pf(__expf(v)); }
__device__ __forceinline__ float wave_sum(float v) {
#pragma unroll
    for (int o = 1; o < 64; o <<= 1) v += __shfl_xor(v, o);
    return v;
}
__device__ __forceinline__ int rowb(int m) { return m < MP ? (m >> 11) : 4 + ((m - MP) >> 2); }
#define LDS_WAIT() asm volatile("s_waitcnt lgkmcnt(0)" ::: "memory")
#define MFMA_SETTLE4(a, b, c, d) do { __builtin_amdgcn_sched_barrier(0); asm volatile("s_nop 15\n\ts_nop 3"); __builtin_amdgcn_sched_barrier(0); } while (0)
#define MFMA_SETTLE1(a) MFMA_SETTLE4(a, a, a, a)

using pg8::Unit; using pg8::HALF; using pg8::BM; using pg8::cvt_pk_bf16;
__device__ __forceinline__ void acc4(float* p, const f32x4 v) { *(f32x4*)p = *(const f32x4*)p + v; }
struct EpiMods { static constexpr bool PERM = false; float* O;
    __device__ __forceinline__ void operator()(const f32x4 (&acc)[2][2][4][2], const Unit& u, int wr, int wc, int fr, int fq) const {
        const int col0 = u.pn * BM + wc * 32 + 4 * fq;
#pragma unroll
        for (int ai = 0; ai < 2; ++ai)
#pragma unroll
            for (int m = 0; m < 4; ++m) { const int r = u.pm * BM + ai * HALF + wr * 64 + m * 16 + fr; if (r >= 132) continue;
#pragma unroll
                for (int bj = 0; bj < 2; ++bj)
#pragma unroll
                    for (int n = 0; n < 2; ++n) acc4(O + (size_t)r * NMOD + col0 + bj * HALF + n * 16, acc[ai][bj][m][n]); }
    }
};
struct EpiSwiglu { static constexpr bool PERM = true; bf16_t* O;
    __device__ __forceinline__ void operator()(const f32x4 (&acc)[2][2][4][2], const Unit& u, int wr, int wc, int fr, int fq) const {
        const int col0 = u.pn * HALF + wc * 32 + 8 * fq;
#pragma unroll
        for (int ai = 0; ai < 2; ++ai)
#pragma unroll
            for (int m = 0; m < 4; ++m) { const int r = u.pm * BM + ai * HALF + wr * 64 + m * 16 + fr;
                float o[8];
#pragma unroll
                for (int n = 0; n < 2; ++n)
#pragma unroll
                    for (int v = 0; v < 4; ++v) o[4 * n + v] = silu_fast(acc[ai][0][m][n][v]) * acc[ai][1][m][n][v];
                u32x4 w; w.x = cvt_pk_bf16(o[0], o[1]); w.y = cvt_pk_bf16(o[2], o[3]); w.z = cvt_pk_bf16(o[4], o[5]); w.w = cvt_pk_bf16(o[6], o[7]);
                *(u32x4*)(O + (size_t)r * DFF + col0) = w; }
    }
};
struct EpiResid { static constexpr bool PERM = false; float* out; const float* gate; float coef; float* part; const float* base_p; const float* base_s;
    __device__ __forceinline__ void operator()(const f32x4 (&acc)[2][2][4][2], const Unit& u, int wr, int wc, int fr, int fq) const {
        const int col0 = u.pn * BM + wc * 32 + 4 * fq;
#pragma unroll
        for (int ai = 0; ai < 2; ++ai)
#pragma unroll
            for (int m = 0; m < 4; ++m) { const int r = u.pm * BM + ai * HALF + wr * 64 + m * 16 + fr;
                const float* grow = gate + (size_t)rowb(r) * NMOD; float* orow = out + (size_t)r * DM; const float* brow = base_p ? (r < MP ? base_p + (size_t)r * DM : base_s + (size_t)(r - MP) * DM) : orow; bf16_t* prow = (bf16_t*)part + (size_t)u.slot * 65536 + (size_t)(r & 255) * 256 - u.pn * BM;
#pragma unroll
                for (int bj = 0; bj < 2; ++bj)
#pragma unroll
                    for (int n = 0; n < 2; ++n) { const int c = col0 + bj * HALF + n * 16;
                        const f32x4 gv = *(const f32x4*)(grow + c); const f32x4 inc = coef * gv * acc[ai][bj][m][n];
                        if (u.atomic) { u32x2 pw; pw.x = pk2(inc.x, inc.y); pw.y = pk2(inc.z, inc.w); *(u32x2*)(prow + c) = pw; } else *(f32x4*)(orow + c) = *(const f32x4*)(brow + c) + inc; } }
    }
};
struct EpiProj { static constexpr bool PERM = true; bf16_t* O; float* dtraw;
    __device__ __forceinline__ void operator()(const f32x4 (&acc)[2][2][4][2], const Unit& u, int wr, int wc, int fr, int fq) const {
        const int col0 = u.pn * BM + wc * 32 + 8 * fq;
        const bool dtt = (u.pn == PC_DT / BM) && (wc < 2);
        const bool zt = (u.pn >= PC_Z / BM) && (u.pn < PC_XBC / BM);
#pragma unroll
        for (int ai = 0; ai < 2; ++ai)
#pragma unroll
            for (int m = 0; m < 4; ++m) { const int r = u.pm * BM + ai * HALF + wr * 64 + m * 16 + fr;
#pragma unroll
                for (int bj = 0; bj < 2; ++bj) { f32x4 v0 = acc[ai][bj][m][0], v1 = acc[ai][bj][m][1];
                    if (zt) { v0[0] = siluf_(v0[0]); v0[1] = siluf_(v0[1]); v0[2] = siluf_(v0[2]); v0[3] = siluf_(v0[3]); v1[0] = siluf_(v1[0]); v1[1] = siluf_(v1[1]); v1[2] = siluf_(v1[2]); v1[3] = siluf_(v1[3]); }
                    u32x4 w; w.x = cvt_pk_bf16(v0[0], v0[1]); w.y = cvt_pk_bf16(v0[2], v0[3]); w.z = cvt_pk_bf16(v1[0], v1[1]); w.w = cvt_pk_bf16(v1[2], v1[3]);
                    *(u32x4*)(O + (size_t)r * DPROJP + col0 + bj * HALF) = w;
                    if (bj == 0 && dtt) { float* d = dtraw + (size_t)r * 64 + wc * 32 + 8 * fq; *(f32x4*)d = v0; *(f32x4*)(d + 4) = v1; } } }
    }
};
struct EpiPlain { static constexpr bool PERM = true; bf16_t* O;
    __device__ __forceinline__ void operator()(const f32x4 (&acc)[2][2][4][2], const Unit& u, int wr, int wc, int fr, int fq) const {
        const int col0 = u.pn * BM + wc * 32 + 8 * fq;
#pragma unroll
        for (int bj = 0; bj < 2; ++bj)
#pragma unroll
            for (int ai = 0; ai < 2; ++ai)
#pragma unroll
                for (int m = 0; m < 4; ++m) { const int r = u.pm * BM + ai * HALF + wr * 64 + m * 16 + fr;
                    const f32x4 v0 = acc[ai][bj][m][0], v1 = acc[ai][bj][m][1];
                    u32x4 w; w.x = cvt_pk_bf16(v0[0], v0[1]); w.y = cvt_pk_bf16(v0[2], v0[3]); w.z = cvt_pk_bf16(v1[0], v1[1]); w.w = cvt_pk_bf16(v1[2], v1[3]);
                    *(u32x4*)(O + (size_t)r * DM + col0 + bj * HALF) = w; }
    }
};
struct EpiScale { static constexpr bool PERM = true; bf16_t* O; const float* scale;
    __device__ __forceinline__ void operator()(const f32x4 (&acc)[2][2][4][2], const Unit& u, int wr, int wc, int fr, int fq) const {
        const int col0 = u.pn * BM + wc * 32 + 8 * fq;
#pragma unroll
        for (int bj = 0; bj < 2; ++bj) { const f32x4 s0 = *(const f32x4*)(scale + col0 + bj * HALF), s1 = *(const f32x4*)(scale + col0 + bj * HALF + 4);
#pragma unroll
            for (int ai = 0; ai < 2; ++ai)
#pragma unroll
                for (int m = 0; m < 4; ++m) { const int r = u.pm * BM + ai * HALF + wr * 64 + m * 16 + fr;
                    const f32x4 v0 = acc[ai][bj][m][0] * s0, v1 = acc[ai][bj][m][1] * s1;
                    u32x4 w; w.x = cvt_pk_bf16(v0[0], v0[1]); w.y = cvt_pk_bf16(v0[2], v0[3]); w.z = cvt_pk_bf16(v1[0], v1[1]); w.w = cvt_pk_bf16(v1[2], v1[3]);
                    *(u32x4*)(O + (size_t)r * DM + col0 + bj * HALF) = w; } }
    }
};
template <bool MERGE> struct EpiGate { static constexpr bool PERM = true; const bf16_t* proj; int gcol; float* tmp; bf16_t* merged; float* part;
    __device__ __forceinline__ void operator()(const f32x4 (&acc)[2][2][4][2], const Unit& u, int wr, int wc, int fr, int fq) const {
        const int col0 = u.pn * BM + wc * 32 + 8 * fq;
#pragma unroll
        for (int ai = 0; ai < 2; ++ai)
#pragma unroll
            for (int m = 0; m < 4; ++m) { const int r = u.pm * BM + ai * HALF + wr * 64 + m * 16 + fr;
#pragma unroll
                for (int bj = 0; bj < 2; ++bj) { const int c = col0 + bj * HALF;
                    const u32x4 gw = *(const u32x4*)(proj + (size_t)r * DPROJP + gcol + c);
                    f32x4 v0 = acc[ai][bj][m][0], v1 = acc[ai][bj][m][1];
                    v0[0] *= sigmoid_fast(bflo(gw.x)); v0[1] *= sigmoid_fast(bfhi(gw.x)); v0[2] *= sigmoid_fast(bflo(gw.y)); v0[3] *= sigmoid_fast(bfhi(gw.y));
                    v1[0] *= sigmoid_fast(bflo(gw.z)); v1[1] *= sigmoid_fast(bfhi(gw.z)); v1[2] *= sigmoid_fast(bflo(gw.w)); v1[3] *= sigmoid_fast(bfhi(gw.w));
                    float* tp = tmp + (size_t)r * DM + c;
                    if (u.atomic) { bf16_t* pp = (bf16_t*)part + (size_t)u.slot * 65536 + (size_t)(r & 255) * 256 + (c - u.pn * BM); u32x4 pw; pw.x = pk2(v0[0], v0[1]); pw.y = pk2(v0[2], v0[3]); pw.z = pk2(v1[0], v1[1]); pw.w = pk2(v1[2], v1[3]); *(u32x4*)pp = pw; }
                    else if constexpr (!MERGE) { *(f32x4*)tp = v0; *(f32x4*)(tp + 4) = v1; }
                    else { v0 += *(const f32x4*)tp; v1 += *(const f32x4*)(tp + 4);
                        u32x4 w; w.x = cvt_pk_bf16(v0[0], v0[1]); w.y = cvt_pk_bf16(v0[2], v0[3]); w.z = cvt_pk_bf16(v1[0], v1[1]); w.w = cvt_pk_bf16(v1[2], v1[3]);
                        *(u32x4*)(merged + (size_t)r * DM + c) = w; } } }
    }
};

struct Args { const float* in[29]; float* out; unsigned char* ws; int ph_lo, ph_hi, coop, pad; };
struct Ctx { LAS unsigned char* lds; int tid, lane, wave, G, bid; };

struct TItem { const float* src; bf16_t* dst; int N, K; };
__device__ __forceinline__ int rm_swiglu(int n0) { return n0 < DFF ? (n0 >> 7) * 256 + (n0 & 127) : ((n0 - DFF) >> 7) * 256 + 128 + ((n0 - DFF) & 127); }
__device__ __forceinline__ TItem titem(const float* W, int K, int N, bf16_t* WT, int item, int row_off, bool swiglu) {
    const int nblk = N / 32, kb = item / nblk, nb = item % nblk, k0 = 64 * kb, n0 = 32 * nb;
    TItem t; t.src = W + (size_t)k0 * N + n0; t.dst = WT + (size_t)(swiglu ? rm_swiglu(n0) : row_off + n0) * K + k0; t.N = N; t.K = K; return t;
}
__device__ __forceinline__ TItem p0_decode(const Args& a, int r) {
    unsigned char* ws = a.ws;
    constexpr int I_ADA = 32 * (NMOD / 32), I_13 = 32 * (2 * DFF / 32), I_2 = (DFF / 64) * (DM / 32), I_IN = 32 * (DPROJ / 32), I_PW = 8 * 16, I_BP = 32 * 64, I_BS = 64 * 64;
    if (r < I_ADA) return titem(a.in[7], DM, NMOD, (bf16_t*)(ws + WS_WADA), r, 0, false); r -= I_ADA;
    if (r < I_13) return titem(a.in[10], DM, 2 * DFF, (bf16_t*)(ws + WS_W13A), r, 0, true); r -= I_13;
    if (r < I_2) return titem(a.in[11], DFF, DM, (bf16_t*)(ws + WS_W2A), r, 0, false); r -= I_2;
    if (r < I_IN) return titem(a.in[13], DM, DPROJ, (bf16_t*)(ws + WS_WIN), r, 0, false); r -= I_IN;
    if (r < 4 * I_PW) { const int g = r / I_PW; return titem(a.in[14] + (size_t)g * 512 * 512, 512, 512, (bf16_t*)(ws + WS_YPOOL + 16 * MiB), r % I_PW, g * 512, false); } r -= 4 * I_PW;
    if (r < I_BP) return titem(a.in[22], DM, DM, (bf16_t*)(ws + WS_WBP), r, 0, false); r -= I_BP;
    if (r < I_BS) return titem(a.in[23], DIN, DM, (bf16_t*)(ws + WS_WBS), r, 0, false); r -= I_BS;
    if (r < I_BP) return titem(a.in[24], DM, DM, (bf16_t*)(ws + WS_WOUT), r, 0, false); r -= I_BP;
    if (r < I_13) return titem(a.in[26], DM, 2 * DFF, (bf16_t*)(ws + WS_W13B), r, 0, true); r -= I_13;
    return titem(a.in[27], DFF, DM, (bf16_t*)(ws + WS_W2B), r, 0, false);
}
constexpr int P0_I_ADA = 32 * (NMOD / 32), P0_I_13 = 32 * (2 * DFF / 32), P0_I_2 = (DFF / 64) * (DM / 32), P0_I_IN = 32 * (DPROJ / 32), P0_I_PW = 8 * 16, P0_I_BP = 32 * 64, P0_I_BS = 64 * 64;
constexpr int P0_NITEMS = P0_I_ADA + 2 * P0_I_13 + 2 * P0_I_2 + P0_I_IN + 4 * P0_I_PW + 2 * P0_I_BP + P0_I_BS;
constexpr int P0_EARLY = P0_NITEMS - P0_I_13 - P0_I_2;
constexpr int P0_DEFER_A = P0_EARLY + 4608;
__device__ __forceinline__ void convert_range(const Ctx& F, const Args& a, int it0, int it_end, int stride, int skip_lo = 1 << 30, int skip_len = 0) {
    LAS float* scr = (LAS float*)(F.lds + F.wave * 16384);
    const int lane = F.lane, lr = lane >> 3, lc = 4 * (lane & 7);
    int it = it0;
    f32x4 R[8]; TItem cur;
#define P0_LOAD(T, RR) do { _Pragma("unroll") for (int i = 0; i < 8; ++i) RR[i] = __builtin_nontemporal_load((const f32x4*)((T).src + (size_t)(8 * i + lr) * (T).N + lc)); } while (0)
    if (it < it_end) { cur = p0_decode(a, it >= skip_lo ? it + skip_len : it); P0_LOAD(cur, R); }
    while (it < it_end) {
        const int nit = it + stride; f32x4 Rn[8]; TItem nxt = cur;
        if (nit < it_end) { nxt = p0_decode(a, nit >= skip_lo ? nit + skip_len : nit); P0_LOAD(nxt, Rn); }
#pragma unroll
        for (int i = 0; i < 8; ++i) { LAS float* q = scr + (8 * i + lr) * 33 + lc; q[0] = R[i].x; q[1] = R[i].y; q[2] = R[i].z; q[3] = R[i].w; }
        LDS_WAIT(); asm volatile("" ::: "memory");
        { const int c = lane & 7;
#pragma unroll
          for (int j = 0; j < 4; ++j) { const int n = (lane >> 3) + 8 * j; const LAS float* q = scr + (8 * c) * 33 + n;
              u32x4 o; o.x = pk2(q[0 * 33], q[1 * 33]); o.y = pk2(q[2 * 33], q[3 * 33]); o.z = pk2(q[4 * 33], q[5 * 33]); o.w = pk2(q[6 * 33], q[7 * 33]);
              *(u32x4*)(cur.dst + (size_t)n * cur.K + 8 * c) = o; } }
        LDS_WAIT(); asm volatile("" ::: "memory");
#pragma unroll
        for (int i = 0; i < 8; ++i) R[i] = Rn[i];
        cur = nxt; it = nit;
    }
#undef P0_LOAD
}
__device__ __forceinline__ void p0_prologue(const Ctx& F, const Args& a, int part, int wg0, int nwg) {
    unsigned char* ws = a.ws;
    const int gw = (F.bid - wg0) * 8 + F.wave, NGW = nwg * 8;
    constexpr int BP_LO = P0_I_ADA + P0_I_13 + P0_I_2 + P0_I_IN + 4 * P0_I_PW;
    if (part == 0) { convert_range(F, a, gw, P0_I_ADA, NGW); convert_range(F, a, BP_LO + gw, BP_LO + P0_I_BP, NGW); }
    else convert_range(F, a, gw + P0_I_ADA, P0_EARLY - P0_I_BP, NGW, BP_LO, P0_I_BP);
    if (part != 0) return;
    { u32x4* z = (u32x4*)((bf16_t*)(ws + WS_WIN) + (size_t)DPROJ * DM); const int n16 = (DPROJP - DPROJ) * DM * 2 / 16;
      for (int i = F.bid * 512 + F.tid; i < n16; i += F.G * 512) z[i] = (u32x4){0u, 0u, 0u, 0u}; }
    { bf16_t* pws = (bf16_t*)(ws + WS_WPOOL); for (int i = F.bid * 512 + F.tid; i < 4 * 512 * 512 / 4; i += F.G * 512) { const int e = i * 4, cc = e >> 9, d = e & 511;
        const f32x4 w4 = *(const f32x4*)(a.in[14] + e), s4 = *(const f32x4*)(a.in[15] + (cc >> 9) * 512 + d); u32x2 o; o.x = pk2(w4.x * s4.x, w4.y * s4.y); o.y = pk2(w4.z * s4.z, w4.w * s4.w); *(u32x2*)(pws + e) = o; } }
    { float* mods = (float*)(ws + WS_MODS); for (int i = F.bid * 512 + F.tid; i < 132 * NMOD / 4; i += F.G * 512) { const int c = (i % (NMOD / 4)) * 4; *(f32x4*)(mods + (size_t)(i / (NMOD / 4)) * NMOD + c) = *(const f32x4*)(a.in[8] + c); } }
    { bf16_t* Ac = (bf16_t*)(ws + WS_AC);
      for (int i = F.bid * 512 + F.tid; i < 256 * DM / 2; i += F.G * 512) { const int r = i / (DM / 2), c = (i % (DM / 2)) * 2;
          unsigned w = 0u;
          if (r < 132) { const float* src = r < 4 ? a.in[2] + (size_t)r * DM : a.in[3] + (size_t)(r - 4) * DM; w = pk2(siluf_(src[c]), siluf_(src[c + 1])); }
          *(unsigned*)(Ac + (size_t)r * DM + c) = w; } }
}

__device__ __forceinline__ void norm_mod_rows(const Ctx& F, const float* xp, const float* xs, const float* gamma, const float* mods, int sh_off, int sc_off, bf16_t* out, const float* fixb_p, const float* fixb_s, const float* part, int S, const LAS int* tmap) {
    const int gw = F.bid * 8 + F.wave, NGW = F.G * 8;
    f32x4 gm[8];
#pragma unroll
    for (int j = 0; j < 8; ++j) gm[j] = *(const f32x4*)(gamma + 4 * F.lane + 256 * j);
    for (int m = gw; m < MT; m += NGW) {
        float* xrow = (float*)((m < MP) ? xp + (size_t)m * DM : xs + (size_t)(m - MP) * DM);
        const f32x4* xr = (const f32x4*)xrow + F.lane;
        f32x4 v[8]; float s = 0.f;
#pragma unroll
        for (int j = 0; j < 8; ++j) v[j] = xr[64 * j];
        if (S > 1) {
#pragma unroll
            for (int j = 0; j < 8; ++j) { const int un = tmap[(m >> 8) * 8 + j]; if (un >= 0) { f32x4 q = (f32x4){0.f, 0.f, 0.f, 0.f};
                const bf16_t* pb_ = (const bf16_t*)part + (size_t)(un * S) * 65536 + (m & 255) * 256 + 4 * F.lane;
                if (S == 16) {
                    u32x2 pw[16];
#pragma unroll
                    for (int pc = 0; pc < 16; ++pc) pw[pc] = *(const u32x2*)(pb_ + (size_t)pc * 65536);
#pragma unroll
                    for (int pc = 0; pc < 16; ++pc) q += (f32x4){bflo(pw[pc].x), bfhi(pw[pc].x), bflo(pw[pc].y), bfhi(pw[pc].y)};
                } else for (int pc = 0; pc < S; ++pc) { const u32x2 pw = *(const u32x2*)(pb_ + (size_t)pc * 65536); q += (f32x4){bflo(pw.x), bfhi(pw.x), bflo(pw.y), bfhi(pw.y)}; }
                if (fixb_p) v[j] = ((const f32x4*)((m < MP) ? fixb_p + (size_t)m * DM : fixb_s + (size_t)(m - MP) * DM))[F.lane + 64 * j];
                v[j] += q; ((f32x4*)xrow)[F.lane + 64 * j] = v[j]; } } }
        const float* mr = mods + (size_t)rowb(m) * NMOD;
        f32x4 scv[8], shv[8];
#pragma unroll
        for (int j = 0; j < 8; ++j) { const int c = 4 * F.lane + 256 * j; scv[j] = *(const f32x4*)(mr + sc_off + c); shv[j] = *(const f32x4*)(mr + sh_off + c); }
#pragma unroll
        for (int j = 0; j < 8; ++j) s += (v[j].x * v[j].x + v[j].y * v[j].y) + (v[j].z * v[j].z + v[j].w * v[j].w);
        const float rinv = 1.0f / sqrtf(wave_sum(s) * (1.0f / DM) + EPS);
        u32x2* o8 = (u32x2*)(out + (size_t)m * DM) + F.lane;
#pragma unroll
        for (int j = 0; j < 8; ++j) {
            const f32x4 y = (v[j] * rinv * gm[j]) * (1.0f + scv[j]) + shv[j];
            u32x2 w; w.x = pk2(y.x, y.y); w.y = pk2(y.z, y.w); o8[64 * j] = w; }
    }
}
__device__ __forceinline__ void final_norm_rows(const Ctx& F, const float* h, const float* gamma, float* out, const float* part, int S, const LAS int* tmap) {
    const int gw = F.bid * 8 + F.wave, NGW = F.G * 8;
    f32x4 gm[8];
#pragma unroll
    for (int j = 0; j < 8; ++j) gm[j] = *(const f32x4*)(gamma + 4 * F.lane + 256 * j);
    for (int m = gw; m < MT; m += NGW) {
        const f32x4* xr = (const f32x4*)(h + (size_t)m * DM) + F.lane;
        f32x4 v[8]; float s = 0.f;
#pragma unroll
        for (int j = 0; j < 8; ++j) v[j] = xr[64 * j];
        if (S > 1) {
#pragma unroll
            for (int j = 0; j < 8; ++j) { const int un = tmap[(m >> 8) * 8 + j]; if (un >= 0) { f32x4 q = (f32x4){0.f, 0.f, 0.f, 0.f};
                const bf16_t* pb_ = (const bf16_t*)part + (size_t)(un * S) * 65536 + (m & 255) * 256 + 4 * F.lane;
                if (S == 16) {
                    u32x2 pw[16];
#pragma unroll
                    for (int pc = 0; pc < 16; ++pc) pw[pc] = *(const u32x2*)(pb_ + (size_t)pc * 65536);
#pragma unroll
                    for (int pc = 0; pc < 16; ++pc) q += (f32x4){bflo(pw[pc].x), bfhi(pw[pc].x), bflo(pw[pc].y), bfhi(pw[pc].y)};
                } else for (int pc = 0; pc < S; ++pc) { const u32x2 pw = *(const u32x2*)(pb_ + (size_t)pc * 65536); q += (f32x4){bflo(pw.x), bfhi(pw.x), bflo(pw.y), bfhi(pw.y)}; }
                v[j] += q; } } }
#pragma unroll
        for (int j = 0; j < 8; ++j) s += (v[j].x * v[j].x + v[j].y * v[j].y) + (v[j].z * v[j].z + v[j].w * v[j].w);
        const float rinv = 1.0f / sqrtf(wave_sum(s) * (1.0f / DM) + EPS);
        f32x4* o = (f32x4*)(out + (size_t)m * DM) + F.lane;
#pragma unroll
        for (int j = 0; j < 8; ++j) o[64 * j] = v[j] * rinv * gm[j];
    }
}

constexpr int SP = 272;
constexpr int SC_XT = 0, SC_BN = 34816, SC_WM = 69632, SC_HB = 104448, SC_S = 139264, SC_DT = SC_S + 512, SC_W = SC_S + 1024, SC_E = SC_S + 1536, SC_END = SC_S + 2048;
static_assert(SC_END <= LDS_BYTES - 64, "scan LDS map");

template <int W> __device__ __forceinline__ void pool_prompt_run(const bf16_t* U, bf16_t* P, float* OPp, int t0) {
    u32x2 r[W - 1 + 16];
#pragma unroll
    for (int i = 0; i < W - 1 + 16; ++i) { const int row = t0 - (W - 1) + i; r[i] = row >= 0 ? *(const u32x2*)(U + (ptrdiff_t)row * DPROJP) : (u32x2){0u, 0u}; }
    float s0 = 0.f, s1 = 0.f, s2 = 0.f, s3 = 0.f;
#pragma unroll
    for (int i = 0; i < W - 1; ++i) { s0 += bflo(r[i].x); s1 += bfhi(r[i].x); s2 += bflo(r[i].y); s3 += bfhi(r[i].y); }
#pragma unroll
    for (int j = 0; j < 16; ++j) { const int t = t0 + j; const u32x2 q = r[W - 1 + j]; const float u0 = bflo(q.x), u1 = bfhi(q.x), u2 = bflo(q.y), u3 = bfhi(q.y);
        s0 += u0; s1 += u1; s2 += u2; s3 += u3;
        const float ic = 1.0f / (float)(t + 1 < W ? t + 1 : W);
        u32x2 o; o.x = pk2(s0 * ic - u0, s1 * ic - u1); o.y = pk2(s2 * ic - u2, s3 * ic - u3);
        *(u32x2*)(P + (size_t)t * DM) = o;
        s0 -= bflo(r[j].x); s1 -= bfhi(r[j].x); s2 -= bflo(r[j].y); s3 -= bfhi(r[j].y);
        if (t >= SEQ - 15) *(f32x4*)(OPp + (size_t)(t - (SEQ - 15)) * DM) = (f32x4){u0, u1, u2, u3}; }
}
__device__ __forceinline__ void pool_prompt_item(const Ctx& F, int item, const bf16_t* proj, bf16_t* pooled, float* out) {
    const int b = item >> 7, t0 = (item & 127) * 16, c0 = 4 * F.tid, g = F.tid >> 7;
    const bf16_t* U = proj + (size_t)b * SEQ * DPROJP + PC_POOL + c0;
    bf16_t* P = pooled + (size_t)b * SEQ * DM + c0;
    float* OPp = out + O_PPOOL + (size_t)b * 15 * DM + c0;
    if (g == 0) pool_prompt_run<2>(U, P, OPp, t0); else if (g == 1) pool_prompt_run<4>(U, P, OPp, t0); else if (g == 2) pool_prompt_run<8>(U, P, OPp, t0); else pool_prompt_run<16>(U, P, OPp, t0);
}
template <int W> __device__ __forceinline__ void pool_sample_run(const bf16_t* U, const float* SPp, bf16_t* P, float* OP) {
    f32x4 f[19];
#pragma unroll
    for (int r = 0; r < 15; ++r) f[r] = *(const f32x4*)(SPp + (size_t)r * DM);
#pragma unroll
    for (int t = 0; t < 4; ++t) { const u32x2 q = *(const u32x2*)(U + (size_t)t * DPROJP); f[15 + t] = (f32x4){bflo(q.x), bfhi(q.x), bflo(q.y), bfhi(q.y)}; }
    f32x4 s = (f32x4){0.f, 0.f, 0.f, 0.f};
#pragma unroll
    for (int r = 15 - W + 1; r < 15; ++r) s += f[r];
#pragma unroll
    for (int t = 0; t < 4; ++t) { s += f[15 + t]; const f32x4 pv = s * (1.0f / (float)W) - f[15 + t];
        u32x2 o; o.x = pk2(pv.x, pv.y); o.y = pk2(pv.z, pv.w); *(u32x2*)(P + (size_t)t * DM) = o; s -= f[15 + t - W + 1]; }
#pragma unroll
    for (int r = 4; r < 19; ++r) *(f32x4*)(OP + (size_t)(r - 4) * DM) = f[r];
}
__device__ __forceinline__ void pool_sample_item(const Ctx& F, int bb, const bf16_t* proj, const float* spool, bf16_t* pooled, float* out) {
    const int c0 = 4 * F.tid, g = F.tid >> 7;
    const bf16_t* U = proj + (size_t)(MP + 4 * bb) * DPROJP + PC_POOL + c0;
    const float* SPp = spool + (size_t)bb * 15 * DM + c0;
    bf16_t* P = pooled + (size_t)(MP + 4 * bb) * DM + c0;
    float* OP = out + O_SPOOL + (size_t)bb * 15 * DM + c0;
    if (g == 0) pool_sample_run<2>(U, SPp, P, OP); else if (g == 1) pool_sample_run<4>(U, SPp, P, OP); else if (g == 2) pool_sample_run<8>(U, SPp, P, OP); else pool_sample_run<16>(U, SPp, P, OP);
}

__device__ __forceinline__ void prepass_phase(const Ctx& F, const Args& a) {
    unsigned char* ws = a.ws;
    const bf16_t* proj = (const bf16_t*)(ws + WS_PROJ); bf16_t* xact = (bf16_t*)(ws + WS_XACT); float* dtv = (float*)(ws + WS_DTRAW); bf16_t* pooled = (bf16_t*)(ws + WS_POOLED);
    const float* cwt = a.in[16]; const float* cbs = a.in[17];
    const int gtid = F.bid * 512 + F.tid, NT = F.G * 512;
    for (int id = gtid; id < NB * 128 * 768; id += NT) {
        const int oc = id % 768, run = id / 768, b = run >> 7, t0 = (run & 127) * 16, ch = oc * 8;
        const bf16_t* src = proj + (size_t)(b * SEQ + t0) * DPROJP + PC_XBC + ch;
        u32x4 r[19];
#pragma unroll
        for (int i = 0; i < 19; ++i) r[i] = (t0 - 3 + i >= 0) ? *(const u32x4*)(src + (ptrdiff_t)(i - 3) * DPROJP) : (u32x4){0u, 0u, 0u, 0u};
        f32x4 w[4][2], bs[2];
#pragma unroll
        for (int k = 0; k < 4; ++k) { w[k][0] = *(const f32x4*)(cwt + (size_t)k * CONVD + ch); w[k][1] = *(const f32x4*)(cwt + (size_t)k * CONVD + ch + 4); }
        bs[0] = *(const f32x4*)(cbs + ch); bs[1] = *(const f32x4*)(cbs + ch + 4);
        bf16_t* dst = xact + (size_t)(b * SEQ + t0) * CONVD + ch;
#pragma unroll
        for (int j = 0; j < 16; ++j) { f32x4 o0 = bs[0], o1 = bs[1];
#pragma unroll
            for (int k = 0; k < 4; ++k) { const u32x4 q = r[j + k];
                o0 += w[k][0] * (f32x4){bflo(q.x), bfhi(q.x), bflo(q.y), bfhi(q.y)}; o1 += w[k][1] * (f32x4){bflo(q.z), bfhi(q.z), bflo(q.w), bfhi(q.w)}; }
            u32x4 pw; pw.x = pk2(siluf_(o0.x), siluf_(o0.y)); pw.y = pk2(siluf_(o0.z), siluf_(o0.w)); pw.z = pk2(siluf_(o1.x), siluf_(o1.y)); pw.w = pk2(siluf_(o1.z), siluf_(o1.w));
            *(u32x4*)(dst + (size_t)j * CONVD) = pw; }
        if (t0 == SEQ - 16) {
#pragma unroll
            for (int jj = 0; jj < 3; ++jj) { const u32x4 q = r[16 + jj]; float* o = a.out + O_PCONV + ((size_t)b * 3 + jj) * CONVD + ch;
                *(f32x4*)o = (f32x4){bflo(q.x), bfhi(q.x), bflo(q.y), bfhi(q.y)}; *(f32x4*)(o + 4) = (f32x4){bflo(q.z), bfhi(q.z), bflo(q.w), bfhi(q.w)}; } }
    }
    for (int id = gtid; id < DB * 768; id += NT) {
        const int oc = id % 768, bb = id / 768, ch = oc * 8;
        f32x4 f[7][2];
#pragma unroll
        for (int r = 0; r < 3; ++r) { const float* sp = a.in[5] + ((size_t)bb * 3 + r) * CONVD + ch; f[r][0] = *(const f32x4*)sp; f[r][1] = *(const f32x4*)(sp + 4); }
#pragma unroll
        for (int r = 0; r < 4; ++r) { const u32x4 q = *(const u32x4*)(proj + (size_t)(MP + 4 * bb + r) * DPROJP + PC_XBC + ch);
            f[3 + r][0] = (f32x4){bflo(q.x), bfhi(q.x), bflo(q.y), bfhi(q.y)}; f[3 + r][1] = (f32x4){bflo(q.z), bfhi(q.z), bflo(q.w), bfhi(q.w)}; }
        f32x4 w[4][2], bs[2];
#pragma unroll
        for (int k = 0; k < 4; ++k) { w[k][0] = *(const f32x4*)(cwt + (size_t)k * CONVD + ch); w[k][1] = *(const f32x4*)(cwt + (size_t)k * CONVD + ch + 4); }
        bs[0] = *(const f32x4*)(cbs + ch); bs[1] = *(const f32x4*)(cbs + ch + 4);
#pragma unroll
        for (int t = 0; t < 4; ++t) { f32x4 o0 = bs[0], o1 = bs[1];
#pragma unroll
            for (int k = 0; k < 4; ++k) { o0 += w[k][0] * f[t + k][0]; o1 += w[k][1] * f[t + k][1]; }
            u32x4 pw; pw.x = pk2(siluf_(o0.x), siluf_(o0.y)); pw.y = pk2(siluf_(o0.z), siluf_(o0.w)); pw.z = pk2(siluf_(o1.x), siluf_(o1.y)); pw.w = pk2(siluf_(o1.z), siluf_(o1.w));
            *(u32x4*)(xact + (size_t)(MP + 4 * bb + t) * CONVD + ch) = pw; }
#pragma unroll
        for (int jj = 0; jj < 3; ++jj) { float* o = a.out + O_SCONV + ((size_t)bb * 3 + jj) * CONVD + ch; *(f32x4*)o = f[4 + jj][0]; *(f32x4*)(o + 4) = f[4 + jj][1]; }
    }
    for (int id = gtid; id < MT * 64 / 4; id += NT) { f32x4 v = *(const f32x4*)(dtv + (size_t)id * 4); const f32x4 bb4 = *(const f32x4*)(a.in[18] + (id & 15) * 4);
        v.x = softplusf_(v.x + bb4.x); v.y = softplusf_(v.y + bb4.y); v.z = softplusf_(v.z + bb4.z); v.w = softplusf_(v.w + bb4.w); *(f32x4*)(dtv + (size_t)id * 4) = v; }
    for (int it = F.bid; it < NB * 128; it += F.G) pool_prompt_item(F, it, proj, pooled, a.out);
    for (int it = F.bid; it < DB; it += F.G) pool_sample_item(F, it, proj, a.in[6], pooled, a.out);
}

__device__ __forceinline__ void scan_prompt_item(const Ctx& F, int b, int h, const Args& a, const bf16_t* proj, const bf16_t* xact, const float* dtv, bf16_t* ygated, float* ssq) {
    LAS unsigned char* L = F.lds;
    const int tid = F.tid, w = F.wave, lane = F.lane, fr = lane & 15, fq = lane >> 4, g = h >> 3;
    const float aneg = -__expf(a.in[19][h]), Dk = a.in[20][h];
    LAS float* sS = (LAS float*)(L + SC_S); LAS float* sDT = (LAS float*)(L + SC_DT); LAS float* sW = (LAS float*)(L + SC_W); LAS float* sE = (LAS float*)(L + SC_E);
    __syncthreads();
    for (int i = tid; i < 17408 / 4; i += 512) ((LAS unsigned*)(L + SC_HB))[i] = 0u;
    f32x4 hreg[4];
#pragma unroll
    for (int pt = 0; pt < 4; ++pt) hreg[pt] = (f32x4){0.f, 0.f, 0.f, 0.f};
    u32x4 px[2], pb[4], pc[4]; float pd0 = 0.f, pd1 = 0.f;
#define SCAN_LOAD(cc) do { const int m0_ = b * SEQ + (cc) * 128; \
        _Pragma("unroll") for (int i = 0; i < 2; ++i) { const int v = tid + 512 * i; px[i] = *(const u32x4*)(xact + (size_t)(m0_ + (v >> 3)) * CONVD + h * 64 + 8 * (v & 7)); } \
        _Pragma("unroll") for (int i = 0; i < 4; ++i) { const int v = tid + 512 * i; pb[i] = *(const u32x4*)(xact + (size_t)(m0_ + (v >> 4)) * CONVD + DIN + g * 128 + 8 * (v & 15)); } \
        _Pragma("unroll") for (int ks = 0; ks < 4; ++ks) pc[ks] = *(const u32x4*)(xact + (size_t)(m0_ + 16 * w + fr) * CONVD + DIN + 1024 + g * 128 + 32 * ks + 8 * fq); \
        if (w == 0) { pd0 = dtv[(size_t)(m0_ + 2 * lane) * 64 + h]; pd1 = dtv[(size_t)(m0_ + 2 * lane + 1) * 64 + h]; } } while (0)
    SCAN_LOAD(0);
    for (int c = 0; c < 16; ++c) {
        const int m0 = b * SEQ + c * 128;
        __syncthreads();
        u32x2 zr[4];
#pragma unroll
        for (int pt = 0; pt < 4; ++pt) zr[pt] = *(const u32x2*)(proj + (size_t)(m0 + 16 * w + fr) * DPROJP + PC_Z + h * 64 + 16 * pt + 4 * fq);
#pragma unroll
        for (int i = 0; i < 2; ++i) { const int v = tid + 512 * i, pg = v & 7, s_ = v >> 3; const unsigned q[4] = {px[i].x, px[i].y, px[i].z, px[i].w};
#pragma unroll
            for (int e = 0; e < 4; ++e) { *(LAS bf16_t*)(L + SC_XT + (8 * pg + 2 * e) * SP + s_ * 2) = (bf16_t)(q[e] & 0xffffu); *(LAS bf16_t*)(L + SC_XT + (8 * pg + 2 * e + 1) * SP + s_ * 2) = (bf16_t)(q[e] >> 16); } }
#pragma unroll
        for (int i = 0; i < 4; ++i) { const int v = tid + 512 * i; *(LAS u32x4*)(L + SC_BN + (v >> 4) * SP + (v & 15) * 16) = pb[i]; }
        bf16x8 Cf[4];
#pragma unroll
        for (int ks = 0; ks < 4; ++ks) Cf[ks] = __builtin_bit_cast(bf16x8, pc[ks]);
        if (w == 0) {
            const float d0 = pd0, d1 = pd1, l0 = d0 * aneg, l1 = d1 * aneg; float inc = l0 + l1;
#pragma unroll
            for (int o = 1; o < 64; o <<= 1) { const float v = __shfl_up(inc, o); if (lane >= o) inc += v; }
            const float s1 = inc, s0 = inc - l1, slast = __shfl(inc, 63);
            sS[2 * lane] = s0; sS[2 * lane + 1] = s1; sDT[2 * lane] = d0; sDT[2 * lane + 1] = d1;
            sW[2 * lane] = __expf(slast - s0) * d0; sW[2 * lane + 1] = __expf(slast - s1) * d1; sE[2 * lane] = __expf(s0); sE[2 * lane + 1] = __expf(s1);
        }
        if (c < 15) SCAN_LOAD(c + 1);
        __syncthreads();
        const float st = sS[16 * w + fr];
        for (int j = 0; j <= w; ++j) {
            f32x4 d = (f32x4){0.f, 0.f, 0.f, 0.f};
#pragma unroll
            for (int ks = 0; ks < 4; ++ks) { const bf16x8 bfr = *(const LAS bf16x8*)(L + SC_BN + (16 * j + fr) * SP + (32 * ks + 8 * fq) * 2); d = __builtin_amdgcn_mfma_f32_16x16x32_bf16(bfr, Cf[ks], d, 0, 0, 0); }
            MFMA_SETTLE1(d);
            const f32x4 ss4 = *(const LAS f32x4*)(sS + 16 * j + 4 * fq), dt4 = *(const LAS f32x4*)(sDT + 16 * j + 4 * fq);
            float wv[4];
#pragma unroll
            for (int v = 0; v < 4; ++v) { const int si = 16 * j + 4 * fq + v; wv[v] = (si <= 16 * w + fr) ? d[v] * __expf(st - ss4[v]) * dt4[v] : 0.f; }
            u32x2 pw; pw.x = pk2(wv[0], wv[1]); pw.y = pk2(wv[2], wv[3]);
            *(LAS u32x2*)(L + SC_WM + (16 * w + fr) * SP + (16 * j + 4 * fq) * 2) = pw;
        }
        if ((w & 1) == 0) *(LAS u32x2*)(L + SC_WM + (16 * w + fr) * SP + (16 * (w + 1) + 4 * fq) * 2) = (u32x2){0u, 0u};
        LDS_WAIT(); asm volatile("" ::: "memory");
        f32x4 accO[4], accD[4];
        const int hbo = SC_HB + (c & 1) * 17408;
#pragma unroll
        for (int pt = 0; pt < 4; ++pt) { accO[pt] = (f32x4){0.f, 0.f, 0.f, 0.f}; accD[pt] = (f32x4){0.f, 0.f, 0.f, 0.f};
#pragma unroll
            for (int ks = 0; ks < 4; ++ks) { const bf16x8 X = *(const LAS bf16x8*)(L + hbo + (16 * pt + fr) * SP + (32 * ks + 8 * fq) * 2); accO[pt] = __builtin_amdgcn_mfma_f32_16x16x32_bf16(X, Cf[ks], accO[pt], 0, 0, 0); } }
        const int nks = (w >> 1) + 1;
        for (int ks = 0; ks < nks; ++ks) { const bf16x8 Y = *(const LAS bf16x8*)(L + SC_WM + (16 * w + fr) * SP + (32 * ks + 8 * fq) * 2);
#pragma unroll
            for (int pt = 0; pt < 4; ++pt) { const bf16x8 X = *(const LAS bf16x8*)(L + SC_XT + (16 * pt + fr) * SP + (32 * ks + 8 * fq) * 2); accD[pt] = __builtin_amdgcn_mfma_f32_16x16x32_bf16(X, Y, accD[pt], 0, 0, 0); } }
        MFMA_SETTLE4(accO[0], accO[1], accO[2], accO[3]);
        {
            const float et = sE[16 * w + fr]; const int mrow = m0 + 16 * w + fr; float q = 0.f;
#pragma unroll
            for (int pt = 0; pt < 4; ++pt) { const int p0 = 16 * pt + 4 * fq;
                const float zv[4] = {bflo(zr[pt].x), bfhi(zr[pt].x), bflo(zr[pt].y), bfhi(zr[pt].y)}; float y[4];
#pragma unroll
                for (int v = 0; v < 4; ++v) { const float xv = bf1(*(const LAS bf16_t*)(L + SC_XT + (p0 + v) * SP + (16 * w + fr) * 2));
                    y[v] = (accO[pt][v] * et + accD[pt][v] + Dk * xv) * zv[v]; q += y[v] * y[v]; }
                u32x2 pw; pw.x = pk2(y[0], y[1]); pw.y = pk2(y[2], y[3]);
                *(u32x2*)(ygated + (size_t)mrow * DIN + h * 64 + p0) = pw; }
            q += __shfl_xor(q, 16); q += __shfl_xor(q, 32);
            if (fq == 0) atomicAdd(ssq + (size_t)mrow * 8 + g, q);
        }
        {
            const float es = sE[127];
#pragma unroll
            for (int pt = 0; pt < 4; ++pt) hreg[pt] = hreg[pt] * es;
#pragma unroll
            for (int ks = 0; ks < 4; ++ks) {
                const f32x4 w0 = *(const LAS f32x4*)(sW + 32 * ks + 8 * fq), w1 = *(const LAS f32x4*)(sW + 32 * ks + 8 * fq + 4);
                const float wsv[8] = {w0.x, w0.y, w0.z, w0.w, w1.x, w1.y, w1.z, w1.w};
                unsigned bw[4];
#pragma unroll
                for (int jj = 0; jj < 4; ++jj) { const float lo = bf1(*(const LAS bf16_t*)(L + SC_BN + (32 * ks + 8 * fq + 2 * jj) * SP + (16 * w + fr) * 2)), hi = bf1(*(const LAS bf16_t*)(L + SC_BN + (32 * ks + 8 * fq + 2 * jj + 1) * SP + (16 * w + fr) * 2));
                    bw[jj] = pk2(lo * wsv[2 * jj], hi * wsv[2 * jj + 1]); }
                const bf16x8 Y = __builtin_bit_cast(bf16x8, (u32x4){bw[0], bw[1], bw[2], bw[3]});
#pragma unroll
                for (int pt = 0; pt < 4; ++pt) { const bf16x8 X = *(const LAS bf16x8*)(L + SC_XT + (16 * pt + fr) * SP + (32 * ks + 8 * fq) * 2); hreg[pt] = __builtin_amdgcn_mfma_f32_16x16x32_bf16(X, Y, hreg[pt], 0, 0, 0); }
            }
            MFMA_SETTLE4(hreg[0], hreg[1], hreg[2], hreg[3]);
            const int hbn = SC_HB + ((c + 1) & 1) * 17408;
#pragma unroll
            for (int pt = 0; pt < 4; ++pt)
#pragma unroll
                for (int v = 0; v < 4; ++v) *(LAS bf16_t*)(L + hbn + (16 * pt + 4 * fq + v) * SP + (16 * w + fr) * 2) = (bf16_t)f2bf(hreg[pt][v]);
        }
    }
#undef SCAN_LOAD
    float* hs = a.out + O_PSSM + (size_t)(b * NH + h) * HD * DST;
#pragma unroll
    for (int pt = 0; pt < 4; ++pt)
#pragma unroll
        for (int v = 0; v < 4; ++v) hs[(size_t)(16 * pt + 4 * fq + v) * DST + 16 * w + fr] = hreg[pt][v];
    __syncthreads();
}

__device__ __forceinline__ void scan_sample_item(const Ctx& F, int item, const Args& a, const bf16_t* proj, const bf16_t* xact, const float* dtv, bf16_t* ygated, float* ssq, LAS float* wl) {
    const int bb = item >> 6, h = item & 63, g = h >> 3, lane = F.lane;
    const int mb = MP + 4 * bb;
    const float aneg = -__expf(a.in[19][h]), Dk = a.in[20][h];
    float dt[4], sc[4], xv[4], Bv[4][2], Cv[4][2];
    { float run = 0.f;
#pragma unroll
      for (int t = 0; t < 4; ++t) { dt[t] = dtv[(size_t)(mb + t) * 64 + h]; run += dt[t] * aneg; sc[t] = run;
          const bf16_t* xr = xact + (size_t)(mb + t) * CONVD;
          xv[t] = bf1(xr[h * 64 + lane]);
          const unsigned qb = *(const unsigned*)(xr + DIN + g * 128 + 2 * lane), qc = *(const unsigned*)(xr + DIN + 1024 + g * 128 + 2 * lane);
          Bv[t][0] = bflo(qb); Bv[t][1] = bfhi(qb); Cv[t][0] = bflo(qc); Cv[t][1] = bfhi(qc); } }
    float zq[4];
#pragma unroll
    for (int t = 0; t < 4; ++t) zq[t] = bf1(proj[(size_t)(mb + t) * DPROJP + PC_Z + h * 64 + lane]);
    float yd[4];
#pragma unroll
    for (int t = 0; t < 4; ++t) { yd[t] = 0.f;
#pragma unroll
        for (int s = 0; s <= t; ++s) { const float gts = wave_sum(Cv[t][0] * Bv[s][0] + Cv[t][1] * Bv[s][1]); yd[t] += gts * __expf(sc[t] - sc[s]) * dt[s] * xv[s]; } }
    LAS float* xsl = wl; LAS float* yol = wl + 256;
    { f32x4 q; q.x = __expf(sc[3] - sc[0]) * dt[0] * xv[0]; q.y = __expf(sc[3] - sc[1]) * dt[1] * xv[1]; q.z = __expf(sc[3] - sc[2]) * dt[2] * xv[2]; q.w = dt[3] * xv[3];
      *(LAS f32x4*)(xsl + 4 * lane) = q; }
    LDS_WAIT(); asm volatile("" ::: "memory");
    const float e3 = __expf(sc[3]);
    const float* h0 = a.in[4] + (size_t)(bb * NH + h) * HD * DST + 2 * lane;
    float* h1 = a.out + O_SSSM + (size_t)(bb * NH + h) * HD * DST + 2 * lane;
    const bool b5 = (lane & 32) != 0, b4 = (lane & 16) != 0;
    for (int pb = 0; pb < 64; pb += 16) {
        f32x2 hvb[16];
#pragma unroll
        for (int k = 0; k < 16; ++k) hvb[k] = __builtin_nontemporal_load((const f32x2*)(h0 + (size_t)(pb + k) * DST));
#pragma unroll
        for (int k = 0; k < 16; ++k) { const int p = pb + k; const f32x2 hv = hvb[k];
        const f32x4 xs4 = *(const LAS f32x4*)(xsl + 4 * p);
        f32x2 hn; hn.x = e3 * hv.x + xs4.x * Bv[0][0] + xs4.y * Bv[1][0] + xs4.z * Bv[2][0] + xs4.w * Bv[3][0];
        hn.y = e3 * hv.y + xs4.x * Bv[0][1] + xs4.y * Bv[1][1] + xs4.z * Bv[2][1] + xs4.w * Bv[3][1];
        __builtin_nontemporal_store(hn, (f32x2*)(h1 + (size_t)p * DST));
        const float v0 = Cv[0][0] * hv.x + Cv[0][1] * hv.y, v1 = Cv[1][0] * hv.x + Cv[1][1] * hv.y, v2 = Cv[2][0] * hv.x + Cv[2][1] * hv.y, v3 = Cv[3][0] * hv.x + Cv[3][1] * hv.y;
        float k0 = b5 ? v2 : v0, k1 = b5 ? v3 : v1; const float q0 = b5 ? v0 : v2, q1 = b5 ? v1 : v3;
        k0 += __shfl_xor(q0, 32); k1 += __shfl_xor(q1, 32);
        float kk = b4 ? k1 : k0; const float qq = b4 ? k0 : k1;
        kk += __shfl_xor(qq, 16); kk += __shfl_xor(kk, 8); kk += __shfl_xor(kk, 4); kk += __shfl_xor(kk, 2); kk += __shfl_xor(kk, 1);
        if ((lane & 15) == 0) yol[(lane >> 4) * 64 + p] = kk;
        }
    }
    LDS_WAIT(); asm volatile("" ::: "memory");
#pragma unroll
    for (int t = 0; t < 4; ++t) {
        const float z = zq[t];
        const float y = (yol[t * 64 + lane] * __expf(sc[t]) + yd[t] + Dk * xv[t]) * z;
        ygated[(size_t)(mb + t) * DIN + h * 64 + lane] = (bf16_t)f2bf(y);
        const float q = wave_sum(y * y);
        if (lane == 0) atomicAdd(ssq + (size_t)(mb + t) * 8 + g, q);
    }
    LDS_WAIT(); asm volatile("" ::: "memory");
}

__device__ __forceinline__ void scan_phase(const Ctx& F, const Args& a) {
    unsigned char* ws = a.ws;
    const bf16_t* proj = (const bf16_t*)(ws + WS_PROJ); const bf16_t* xact = (const bf16_t*)(ws + WS_XACT); const float* dtv = (const float*)(ws + WS_DTRAW);
    bf16_t* ygated = (bf16_t*)(ws + WS_YSSM); float* ssq = (float*)(ws + WS_SSQ);
    const int vcu = (F.G % 8 == 0) ? (F.bid % 8) * (F.G / 8) + F.bid / 8 : F.bid;
    const bool sample_first = ((vcu >> 3) & 1) != 0;
    LAS float* wl = (LAS float*)(F.lds + F.wave * 4096);
    if (sample_first) { for (int it = F.bid * 8 + F.wave; it < DB * NH; it += F.G * 8) scan_sample_item(F, it, a, proj, xact, dtv, ygated, ssq, wl); __syncthreads(); }
    for (int it = vcu; it < NB * NH; it += F.G) scan_prompt_item(F, it >> 6, it & 63, a, proj, xact, dtv, ygated, ssq);
    __syncthreads();
    if (!sample_first) { for (int it = F.bid * 8 + F.wave; it < DB * NH; it += F.G * 8) scan_sample_item(F, it, a, proj, xact, dtv, ygated, ssq, wl); __syncthreads(); }
}

__device__ __forceinline__ void ssm_norm_rows(const Ctx& F, bf16_t* y, const float* ssq, const float* gamma) {
    const int gw = F.bid * 8 + F.wave, NGW = F.G * 8;
    for (int m = gw; m < MT; m += NGW) {
#pragma unroll
        for (int j = 0; j < 8; ++j) { const int c = 8 * F.lane + 512 * j;
            const float rinv = 1.0f / sqrtf(ssq[(size_t)m * 8 + j] * (1.0f / 512.0f) + EPS);
            u32x4* p = (u32x4*)(y + (size_t)m * DIN + c); const u32x4 r = *p;
            const f32x4 g0 = *(const f32x4*)(gamma + c), g1 = *(const f32x4*)(gamma + c + 4);
            u32x4 o; o.x = pk2(bflo(r.x) * rinv * g0.x, bfhi(r.x) * rinv * g0.y); o.y = pk2(bflo(r.y) * rinv * g0.z, bfhi(r.y) * rinv * g0.w);
            o.z = pk2(bflo(r.z) * rinv * g1.x, bfhi(r.z) * rinv * g1.y); o.w = pk2(bflo(r.w) * rinv * g1.z, bfhi(r.w) * rinv * g1.w);
            *p = o; }
    }
}

__device__ __forceinline__ void tail_tiles_merge(const Ctx& F, const float* partA, const float* partB, bf16_t* merged) {
    pg8::StaticOrder Sa; Sa.init(MT, DM, DM, F.G, F.bid, true); pg8::StaticOrder Sb; Sb.init(MT, DM, DIN, F.G, F.bid, true); if (Sa.S <= 1) return;
    for (int j = F.bid; j < Sa.tail * 8; j += F.G) { const int un = j >> 3, sub = j & 7; Unit u; Sa.decode(Sa.full + un, u);
        for (int i = F.tid; i < 32 * 64; i += 512) { const int lr = sub * 32 + (i >> 6), lc = (i & 63) * 4; f32x4 v = (f32x4){0.f, 0.f, 0.f, 0.f};
            if (Sa.S == 16 && Sb.S == 16) {
                const bf16_t* pa_ = (const bf16_t*)partA + (size_t)(un * 16) * 65536 + lr * 256 + lc; const bf16_t* pb_ = (const bf16_t*)partB + (size_t)(un * 16) * 65536 + lr * 256 + lc;
                u32x2 pw[32];
#pragma unroll
                for (int pc = 0; pc < 16; ++pc) { pw[pc] = *(const u32x2*)(pa_ + (size_t)pc * 65536); pw[16 + pc] = *(const u32x2*)(pb_ + (size_t)pc * 65536); }
#pragma unroll
                for (int pc = 0; pc < 32; ++pc) v += (f32x4){bflo(pw[pc].x), bfhi(pw[pc].x), bflo(pw[pc].y), bfhi(pw[pc].y)};
            } else {
            for (int pc = 0; pc < Sa.S; ++pc) { const u32x2 pw = *(const u32x2*)((const bf16_t*)partA + (size_t)(un * Sa.S + pc) * 65536 + lr * 256 + lc); v += (f32x4){bflo(pw.x), bfhi(pw.x), bflo(pw.y), bfhi(pw.y)}; }
            for (int pc = 0; pc < Sb.S; ++pc) { const u32x2 pw = *(const u32x2*)((const bf16_t*)partB + (size_t)(un * Sb.S + pc) * 65536 + lr * 256 + lc); v += (f32x4){bflo(pw.x), bfhi(pw.x), bflo(pw.y), bfhi(pw.y)}; }
            }
            u32x2 w; w.x = pk2(v.x, v.y); w.y = pk2(v.z, v.w); *(u32x2*)(merged + (size_t)(u.pm * 256 + lr) * DM + u.pn * 256 + lc) = w; } }
}
__device__ __forceinline__ int tail_map_build(const Ctx& F, int K, LAS int* tmap) {
    pg8::StaticOrder St; St.init(MT, DM, K, F.G, F.bid, true);
    __syncthreads();
    for (int i = F.tid; i < 34 * 8; i += 512) tmap[i] = -1;
    __syncthreads();
    if (St.S > 1 && F.tid < St.tail) { Unit u; St.decode(St.full + F.tid, u); tmap[u.pm * 8 + u.pn] = F.tid; }
    __syncthreads();
    return St.S;
}

#define XB_TMO      128
#define XB_XCNT(j)  (256  + 64 * (j))
#define XB_XSUB(j)  (1280 + 64 * (j))
#define XB_XGEN(j)  (2304 + 64 * (j))
#define XB_TOP      3328
#define XB_TOPGEN   3392
#define XCD_BAR_WORDS 3456
#define XB_SPIN_CAP (1u << 22)
__device__ __forceinline__ unsigned xb_ld(unsigned* p)              { return __hip_atomic_load(p, __ATOMIC_RELAXED, __HIP_MEMORY_SCOPE_AGENT); }
__device__ __forceinline__ unsigned xb_add(unsigned* p, unsigned v) { return __hip_atomic_fetch_add(p, v, __ATOMIC_RELAXED, __HIP_MEMORY_SCOPE_AGENT); }
__device__ __forceinline__ unsigned xb_xcc_id() { return (unsigned)__builtin_amdgcn_s_getreg((3 << 11) | 20) & 0xFu; }
#define XB_SPIN(cond, bar) do { unsigned _sp = 0; while (cond) { __builtin_amdgcn_s_sleep(1); \
    if ((++_sp & 255u) == 0u) { if (xb_ld(&(bar)[XB_TMO])) break; if (_sp > XB_SPIN_CAP) { atomicAdd(&(bar)[XB_TMO], 1u); break; } } } } while (0)
struct XcdBarrier { unsigned* bar; unsigned x; volatile LAS unsigned* st; };
__device__ __forceinline__ XcdBarrier xcd_barrier_post(unsigned* bar, volatile LAS unsigned* st) {
    XcdBarrier b; b.bar = bar; b.x = xb_xcc_id(); b.st = st;
    if (threadIdx.x == 0) (void)xb_add(&bar[XB_XCNT(b.x)], 1u);
    return b;
}
__device__ __forceinline__ void xcd_barrier_complete(unsigned* bar, unsigned x, unsigned& nloc, unsigned& nx) {
    const unsigned G = gridDim.x * gridDim.y * gridDim.z;
    unsigned sum, cnt, mine, sp = 0u;
    for (;;) {
        sum = 0u; cnt = 0u; mine = 0u;
#pragma unroll
        for (unsigned j = 0; j < 16; ++j) { const unsigned c = xb_ld(&bar[XB_XCNT(j)]); sum += c; cnt += (c > 0u) ? 1u : 0u; mine = (j == x) ? c : mine; }
        if (sum == G) break;
        __builtin_amdgcn_s_sleep(1);
        if ((++sp & 255u) == 0u) { if (xb_ld(&bar[XB_TMO])) break; if (sp > XB_SPIN_CAP) { atomicAdd(&bar[XB_TMO], 1u); break; } }
    }
    nloc = mine > 0u ? mine : 1u; nx = cnt > 0u ? cnt : 1u;
}
__device__ __forceinline__ void xcd_barrier(const XcdBarrier& b) {
    asm volatile("s_waitcnt vmcnt(0)" ::: "memory");
    __syncthreads();
    if (threadIdx.x == 0) {
        unsigned* bar = b.bar;
        __builtin_amdgcn_s_waitcnt(0);
        unsigned nloc = b.st[0], nx = b.st[1];
        if (nloc == 0u) { xcd_barrier_complete(bar, b.x, nloc, nx); b.st[0] = nloc; b.st[1] = nx; }
        const unsigned old = xb_add(&bar[XB_XSUB(b.x)], 1u);
        const unsigned gen = old / nloc;
        if (old + 1u == (gen + 1u) * nloc) {
            __builtin_amdgcn_fence(__ATOMIC_RELEASE, "agent");
            asm volatile("s_waitcnt vmcnt(0)" ::: "memory");
            const unsigned og = xb_add(&bar[XB_TOP], 1u);
            const unsigned tg = og / nx;
            if (og + 1u == (tg + 1u) * nx) xb_add(&bar[XB_TOPGEN], 1u);
            else XB_SPIN(xb_ld(&bar[XB_TOPGEN]) == tg, bar);
            __builtin_amdgcn_fence(__ATOMIC_ACQUIRE, "agent");
            xb_add(&bar[XB_XGEN(b.x)], 1u);
            asm volatile("s_waitcnt vmcnt(0)" ::: "memory");
        } else {
            XB_SPIN(xb_ld(&bar[XB_XGEN(b.x)]) == gen, bar);
            __builtin_amdgcn_fence(__ATOMIC_ACQUIRE, "agent");
            asm volatile("s_waitcnt vmcnt(0)" ::: "memory");
        }
    }
    __syncthreads();
}

constexpr int NPHASE = 18;
__global__ void __launch_bounds__(512, 2) fwd_megakernel(Args args) {
    extern __shared__ __attribute__((aligned(16))) unsigned char lds_raw[];
    Ctx F; F.lds = (LAS unsigned char*)lds_raw; F.tid = threadIdx.x; F.lane = F.tid & 63; F.wave = __builtin_amdgcn_readfirstlane(F.tid >> 6); F.G = gridDim.x; F.bid = blockIdx.x;
    unsigned char* ws = args.ws;
    const int lo = args.ph_lo, hi = args.ph_hi;
#define IN(k) (lo <= (k) && (k) < hi)
    { volatile LAS unsigned* st = (volatile LAS unsigned*)(F.lds + LDS_BYTES - 64); if (F.tid < 2) st[F.tid] = 0u; }
    __syncthreads();
    XcdBarrier xbar; xbar.bar = nullptr; xbar.x = 0; xbar.st = nullptr;
    if (args.coop) xbar = xcd_barrier_post((unsigned*)(ws + WS_CTL) + 4096, (volatile LAS unsigned*)(F.lds + LDS_BYTES - 64));
    if (args.coop == 2) cg::this_grid().sync();
#define SEAM(k) do { if (IN(k) && IN((k) + 1)) xcd_barrier(xbar); } while (0)
    float* mods = (float*)(ws + WS_MODS); bf16_t* act = (bf16_t*)(ws + WS_ACT); float* hbuf = (float*)(ws + WS_H); bf16_t* hmid = (bf16_t*)(ws + WS_HMID);
    bf16_t* proj = (bf16_t*)(ws + WS_PROJ); float* tmp = (float*)(ws + WS_TMP); bf16_t* merged = (bf16_t*)(ws + WS_ACT);
    pg8::StaticOrder S;
    LAS int* tmapL = (LAS int*)(F.lds + 140000);

    if (IN(0)) { p0_prologue(F, args, 0, 0, F.G); } SEAM(0);
    if (IN(1)) {
        pg8::Gemm g{(const bf16_t*)(ws + WS_AC), (const bf16_t*)(ws + WS_WADA), 256, NMOD, DM, 0, 0}; S.init(256, NMOD, DM, F.G, F.bid, false);
        EpiMods E{mods};
        constexpr int NQ = NMOD / 256;
        pg8::Gemm g2{(const bf16_t*)(ws + WS_WBP), (const bf16_t*)(ws + WS_WPOOL), DM, DM, 512, 2, (size_t)512 * 2, DM}; EpiPlain E2{(bf16_t*)(ws + WS_YPOOL)};
        if (F.G >= NQ + 64) {
            if (F.bid < NQ) { pg8::gemm_phase<EpiMods>(F.lds, g, S, E); __syncthreads(); pg8::StaticOrder S2; S2.init(DM, DM, 512, NQ, F.bid, false); pg8::gemm_phase<EpiPlain>(F.lds, g2, S2, E2); }
            else p0_prologue(F, args, 1, NQ, F.G - NQ);
        } else { pg8::gemm_phase<EpiMods>(F.lds, g, S, E); __syncthreads(); pg8::StaticOrder S2; S2.init(DM, DM, 512, F.G, F.bid, false); pg8::gemm_phase<EpiPlain>(F.lds, g2, S2, E2); __syncthreads(); p0_prologue(F, args, 1, 0, F.G); }
    } SEAM(1);
    if (IN(2)) { norm_mod_rows(F, args.in[0], args.in[1], args.in[9], mods, 0 * DM, 1 * DM, act, nullptr, nullptr, nullptr, 1, nullptr); } SEAM(2);
    if (IN(3)) {
        pg8::Gemm g{act, (const bf16_t*)(ws + WS_W13A), MT, 2 * DFF, DM, 0, 0}; S.init(MT, 2 * DFF, DM, F.G, F.bid, false);
        EpiSwiglu E{hmid}; pg8::gemm_phase<EpiSwiglu>(F.lds, g, S, E);
        if (S.tail > 0 && F.bid >= S.tail) { __syncthreads(); convert_range(F, args, P0_EARLY + (F.bid - S.tail) * 8 + F.wave, P0_DEFER_A, (F.G - S.tail) * 8); }
        else if (S.tail == 0 && F.bid == 0) { __syncthreads(); convert_range(F, args, P0_EARLY + F.wave, P0_DEFER_A, 8); }
    } SEAM(3);
    if (IN(4)) {
        pg8::Gemm g{hmid, (const bf16_t*)(ws + WS_W2A), MT, DM, DFF, 0, 0}; S.init(MT, DM, DFF, F.G, F.bid, true);
        EpiResid E{hbuf, mods + 2 * DM, 0.5f, (float*)(ws + WS_TMP), args.in[0], args.in[1]}; pg8::gemm_phase<EpiResid>(F.lds, g, S, E);
    } SEAM(4);
    if (IN(5)) { const int Sp = tail_map_build(F, DFF, tmapL); norm_mod_rows(F, hbuf, hbuf + (size_t)MP * DM, args.in[12], mods, 3 * DM, 4 * DM, act, args.in[0], args.in[1], (const float*)(ws + WS_TMP), Sp, tmapL); } SEAM(5);
    if (IN(6)) {
        pg8::Gemm g{act, (const bf16_t*)(ws + WS_WIN), MT, DPROJP, DM, 0, 0}; S.init(MT, DPROJP, DM, F.G, F.bid, false);
        EpiProj E{proj, (float*)(ws + WS_DTRAW)}; pg8::gemm_phase<EpiProj>(F.lds, g, S, E);
        if (S.tail > 0 && F.bid >= S.tail) { __syncthreads(); convert_range(F, args, P0_DEFER_A + (F.bid - S.tail) * 8 + F.wave, P0_NITEMS, (F.G - S.tail) * 8); }
        else if (S.tail == 0 && F.bid == 0) { __syncthreads(); convert_range(F, args, P0_DEFER_A + F.wave, P0_NITEMS, 8); }
    } SEAM(6);
    if (IN(7)) { prepass_phase(F, args); } SEAM(7);
    if (IN(8)) { scan_phase(F, args); } SEAM(8);
    if (IN(9)) {
        ssm_norm_rows(F, (bf16_t*)(ws + WS_YSSM), (const float*)(ws + WS_SSQ), args.in[21]);
    }
    if (IN(10)) {
        pg8::Gemm g{(const bf16_t*)(ws + WS_POOLED), (const bf16_t*)(ws + WS_YPOOL), MT, DM, DM, 0, 0}; S.init(MT, DM, DM, F.G, F.bid, true);
        EpiGate<false> E{proj, PC_GP, tmp, nullptr, (float*)(ws + WS_W13A)}; pg8::gemm_phase<EpiGate<false>>(F.lds, g, S, E);
    } SEAM(10);
    if (IN(11)) {
        pg8::Gemm g{(const bf16_t*)(ws + WS_YSSM), (const bf16_t*)(ws + WS_WBS), MT, DM, DIN, 0, 0}; S.init(MT, DM, DIN, F.G, F.bid, true);
        EpiGate<true> E{proj, PC_GS, tmp, merged, (float*)(ws + WS_WIN)}; pg8::gemm_phase<EpiGate<true>>(F.lds, g, S, E);
    } SEAM(11);
    if (IN(12)) { tail_tiles_merge(F, (const float*)(ws + WS_W13A), (const float*)(ws + WS_WIN), merged); } SEAM(12);
    if (IN(13)) {
        pg8::Gemm g{merged, (const bf16_t*)(ws + WS_WOUT), MT, DM, DM, 0, 0}; S.init(MT, DM, DM, F.G, F.bid, true);
        EpiResid E{hbuf, mods + 5 * DM, 1.0f, (float*)(ws + WS_W13A), nullptr, nullptr}; pg8::gemm_phase<EpiResid>(F.lds, g, S, E);
    } SEAM(13);
    if (IN(14)) { const int Sp = tail_map_build(F, DM, tmapL); norm_mod_rows(F, hbuf, hbuf + (size_t)MP * DM, args.in[25], mods, 6 * DM, 7 * DM, act, nullptr, nullptr, (const float*)(ws + WS_W13A), Sp, tmapL); } SEAM(14);
    if (IN(15)) {
        pg8::Gemm g{act, (const bf16_t*)(ws + WS_W13B), MT, 2 * DFF, DM, 0, 0}; S.init(MT, 2 * DFF, DM, F.G, F.bid, false);
        EpiSwiglu E{hmid}; pg8::gemm_phase<EpiSwiglu>(F.lds, g, S, E);
    } SEAM(15);
    if (IN(16)) {
        pg8::Gemm g{hmid, (const bf16_t*)(ws + WS_W2B), MT, DM, DFF, 0, 0}; S.init(MT, DM, DFF, F.G, F.bid, true);
        EpiResid E{hbuf, mods + 8 * DM, 0.5f, (float*)(ws + WS_W13A), nullptr, nullptr}; pg8::gemm_phase<EpiResid>(F.lds, g, S, E);
    } SEAM(16);
    if (IN(17)) { const int Sp = tail_map_build(F, DFF, tmapL); final_norm_rows(F, hbuf, args.in[28], args.out + O_Y, (const float*)(ws + WS_W13A), Sp, tmapL); }
#undef IN
#undef SEAM
}

extern "C" void kernel_launch(void* const* d_in, const int* in_sizes, int n_in, void* d_out, int out_size, void* d_ws, size_t ws_size, hipStream_t stream) {
    static int grid = 0;
    if (grid == 0) {
        if (n_in != 29 || (size_t)out_size != O_END || ws_size < WS_END) { fprintf(stderr, "kernel_launch: unexpected shapes: n_in %d out %d ws %zu (need %zu)\n", n_in, out_size, ws_size, (size_t)WS_END); grid = -1; return; }
        int dev = 0, cus = 0, per_cu = 0;
        hipGetDevice(&dev); hipDeviceGetAttribute(&cus, hipDeviceAttributeMultiprocessorCount, dev);
        if (hipFuncSetAttribute((const void*)fwd_megakernel, hipFuncAttributeMaxDynamicSharedMemorySize, LDS_BYTES) != hipSuccess) { fprintf(stderr, "kernel_launch: hipFuncSetAttribute failed\n"); grid = -1; return; }
        if (hipOccupancyMaxActiveBlocksPerMultiprocessor(&per_cu, (const void*)fwd_megakernel, 512, LDS_BYTES) != hipSuccess || per_cu < 1) { fprintf(stderr, "kernel_launch: occupancy query says %d\n", per_cu); per_cu = 1; }
        (void)hipGetLastError();
        grid = cus;
    }
    if (grid < 0) return;
    hipMemsetAsync((char*)d_ws + WS_CTL, 0, CTL_ZERO_BYTES, stream);
    Args a{};
    for (int i = 0; i < 29; ++i) a.in[i] = (const float*)d_in[i];
    a.out = (float*)d_out; a.ws = (unsigned char*)d_ws;
#if MK_N_LAUNCHES == 1
    a.ph_lo = 0; a.ph_hi = NPHASE; a.coop = 1;
    void* kargs[] = {&a};
    hipError_t e = hipLaunchCooperativeKernel((const void*)fwd_megakernel, dim3(grid), dim3(512), kargs, LDS_BYTES, stream);
    if (e != hipSuccess) fprintf(stderr, "cooperative launch failed: %s (grid %d)\n", hipGetErrorString(e), grid);
#else
    for (int p = 0; p < NPHASE; ++p) { a.ph_lo = p; a.ph_hi = p + 1; a.coop = 0; hipLaunchKernelGGL(fwd_megakernel, dim3(grid), dim3(512), LDS_BYTES, stream, a); }
#endif
}
```

```cpp
#include <hip/hip_runtime.h>
#include <hip/hip_cooperative_groups.h>
#include <cstdio>
#include <cstdint>
namespace cg = cooperative_groups;

#ifndef MK_N_LAUNCHES
#define MK_N_LAUNCHES 1
#endif

#define LAS __attribute__((address_space(3)))
typedef unsigned short bf16_t;
typedef short bf16x8 __attribute__((ext_vector_type(8)));
typedef float f32x4 __attribute__((ext_vector_type(4)));
typedef float f32x2 __attribute__((ext_vector_type(2)));
typedef unsigned u32x4 __attribute__((ext_vector_type(4)));
typedef unsigned u32x2 __attribute__((ext_vector_type(2)));

constexpr int DM = 2048, NB = 4, SEQ = 2048, DB = 128, DS = 4;
constexpr int MP = NB * SEQ, MS = DB * DS, MT = MP + MS;
constexpr int DFF = 5632, DIN = 4096, NH = 64, HD = 64, DST = 128, NG = 8, CONVD = 6144;
constexpr int DPROJ = 16448, DPROJP = 16640;
constexpr int NMOD = 9 * DM;
constexpr int PC_POOL = 0, PC_Z = 2048, PC_XBC = 6144, PC_DT = 12288, PC_GP = 12352, PC_GS = 14400;
constexpr float EPS = 1e-6f;
constexpr size_t O_Y = 0, O_PSSM = 17825792, O_PCONV = 19922944, O_PPOOL = 19996672, O_SSSM = 20119552, O_SCONV = 87228416, O_SPOOL = 89587712, O_END = 93519872;
constexpr size_t MiB = 1u << 20;
constexpr size_t WS_CTL = 0, CTL_ZERO_BYTES = 1 * MiB, WS_SSQ = 512 * 1024;
constexpr size_t WS_W13A = 1 * MiB, WS_W2A = 45 * MiB, WS_WIN = 67 * MiB, WS_WPOOL = 132 * MiB, WS_WBP = 134 * MiB, WS_WBS = 142 * MiB, WS_WOUT = 158 * MiB,
                 WS_W13B = 166 * MiB, WS_W2B = 210 * MiB, WS_WADA = 232 * MiB, WS_TMP = 232 * MiB  , WS_AC = 304 * MiB, WS_MODS = 305 * MiB,
                 WS_ACT = 323 * MiB, WS_H = 357 * MiB, WS_DTRAW = 425 * MiB, WS_POOLED = 428 * MiB, WS_YPOOL = 462 * MiB, WS_YSSM = 496 * MiB, WS_PROJ = 564 * MiB,
                 WS_HMID = 564 * MiB  , WS_XACT = 841 * MiB  , WS_END = 943 * MiB;
constexpr int LDS_BYTES = 155648;

namespace pg8 {
constexpr int BM = 256, BK = 64, HALF = 128, HTB = HALF * BK * 2, STAGE_BYTES = 8 * HTB, NXCD = 8, WGM = 8;
__host__ __device__ __forceinline__ int lds_byte(int r, int c) { const int st = (r >> 4) * 2 + (c >> 5), rr = r & 15, cc = c & 31, ob = rr * 64 + cc * 2; return st * 1024 + (ob ^ (((ob >> 9) & 1) << 5)); }
__host__ __device__ __forceinline__ void stage_rc(int b, int& R, int& C) { const int st = b / 1024, sb = b % 1024, swz = sb ^ (((sb >> 9) & 1) << 5); R = (st >> 1) * 16 + swz / 64; C = (st & 1) * 32 + (swz % 64) / 2; }
__host__ __device__ __forceinline__ int perm32(int rho) { const int n = rho >> 4, i = rho & 15; return 8 * (i >> 2) + 4 * n + (i & 3); }

struct Unit { int pm, pn, kt0, nkt, atomic, slot; };
struct Gemm { const bf16_t* A; const bf16_t* Bt; int M, N, K; int grp_pn; size_t a_grp_bytes; int lda; };

struct StaticOrder {
    int nM, nN, nwg, G, c, nt, full, tail, S;
    __device__ __forceinline__ void init(int M, int N, int K, int G_, int c_, bool allow_split) {
        nM = M / BM; nN = N / BM; nwg = nM * nN; G = G_; c = c_; nt = K / BK;
        full = (nwg / G) * G; tail = nwg - full; S = (allow_split && tail > 0) ? G / tail : 1;
        if (S > nt / 2) S = nt / 2; if (S < 1) S = 1;
    }
    __device__ __forceinline__ void decode(int L, Unit& u) const {
        int wgid = L; { const int q = nwg / NXCD, r = nwg % NXCD, xcd = wgid % NXCD, off = wgid / NXCD; wgid = (xcd < r ? xcd * (q + 1) : r * (q + 1) + (xcd - r) * q) + off; }
        const int nig = WGM * nN, gid = wgid / nig, fm = gid * WGM, gsz = (nM - fm) < WGM ? (nM - fm) : WGM;
        u.pm = fm + ((wgid % nig) % gsz); u.pn = (wgid % nig) / gsz;
    }
    __device__ __forceinline__ bool next(int i, Unit& u) const {
        const long L = (long)i * G + c;
        if (L < full) { decode((int)L, u); u.kt0 = 0; u.nkt = nt; u.atomic = 0; u.slot = 0; return true; }
        if (L >= full + G) return false;
        const int j = (int)(L - full);
        if (S == 1) { if (j >= tail) return false; decode(full + j, u); u.kt0 = 0; u.nkt = nt; u.atomic = 0; u.slot = 0; return true; }
        const int un = j / S, pc = j % S; if (un >= tail) return false;
        decode(full + un, u); const int pairs = nt / 2, p0 = pc * pairs / S, p1 = (pc + 1) * pairs / S;
        u.kt0 = 2 * p0; u.nkt = 2 * (p1 - p0); u.atomic = 1; u.slot = j; return true;
    }
};

__device__ __forceinline__ unsigned cvt_pk_bf16(float lo, float hi) { unsigned r; asm volatile("v_cvt_pk_bf16_f32 %0, %1, %2" : "=v"(r) : "v"(lo), "v"(hi)); return r; }

template <class Epi, bool ALIGN_EPI = true>
__device__ __forceinline__ void gemm_phase(LAS unsigned char* lds, const Gemm g, const StaticOrder& S, const Epi& E) {
    int tid_ = threadIdx.x; asm volatile("" : "+v"(tid_));
    const int tid = tid_, wid = __builtin_amdgcn_readfirstlane(tid >> 6), lane = tid & 63, wr = wid >> 2, wc = wid & 3, fr = lane & 15, fq = lane >> 4;
    const int K = g.K;
    unsigned voffA[2], voffB[2];
#pragma unroll
    for (int i = 0; i < 2; ++i) { int R, C; stage_rc(tid * 16 + i * 8192, R, C); const int Rb = Epi::PERM ? ((R & ~31) + perm32(R & 31)) : R;
        voffA[i] = (unsigned)(R * (g.lda ? g.lda : K) + C) * 2u; voffB[i] = (unsigned)(Rb * K + C) * 2u; }
    const size_t kstep = (size_t)(BK * 2);
    const size_t hstep = (size_t)HALF * K * 2;
    const size_t tstep = 2 * hstep;
    const size_t hstepA = (size_t)HALF * (g.lda ? g.lda : K) * 2, tstepA = 2 * hstepA;
    const unsigned ldsw = (unsigned)wid * 1024u;
    const int aoff = lds_byte(wr * 64 + fr, fq * 8), boff = lds_byte(wc * 32 + fr, fq * 8);
#define PG8_SA(b, h) (((b) * 2 + (h)) * HTB)
#define PG8_SB(b, h) ((4 + (b) * 2 + (h)) * HTB)
#define PG8_STAGE(bufoff, gbase, voff) do { _Pragma("unroll") for (int _i = 0; _i < 2; ++_i) \
        __builtin_amdgcn_global_load_lds((const unsigned*)((const char*)(gbase) + (voff)[_i]), (LAS unsigned*)(lds + (bufoff) + ldsw + _i * 8192), 16, 0, 0); } while (0)
#define PG8_LDA(dst, b, h) do { _Pragma("unroll") for (int m = 0; m < 4; ++m) _Pragma("unroll") for (int k = 0; k < 2; ++k) dst[m][k] = *(const LAS bf16x8*)(lds + PG8_SA(b, h) + aoff + m * 2048 + k * 1024); } while (0)
#define PG8_LDB(dst, b, h) do { _Pragma("unroll") for (int n = 0; n < 2; ++n) _Pragma("unroll") for (int k = 0; k < 2; ++k) dst[n][k] = *(const LAS bf16x8*)(lds + PG8_SB(b, h) + boff + n * 2048 + k * 1024); } while (0)
#define PG8_MMA(ai, bj, At, Bt) do { __builtin_amdgcn_s_setprio(1); _Pragma("unroll") for (int m = 0; m < 4; ++m) _Pragma("unroll") for (int n = 0; n < 2; ++n) _Pragma("unroll") for (int k = 0; k < 2; ++k) \
        acc[ai][bj][m][n] = __builtin_amdgcn_mfma_f32_16x16x32_bf16(Bt[n][k], At[m][k], acc[ai][bj][m][n], 0, 0, 0); __builtin_amdgcn_s_setprio(0); } while (0)
#define PG8_WAIT_V(n) asm volatile("s_waitcnt vmcnt(" #n ")" ::: "memory")
#define PG8_WAIT_L(n) asm volatile("s_waitcnt lgkmcnt(" #n ")" ::: "memory")
#define PG8_BAR __builtin_amdgcn_s_barrier()
#define PG8_SCHED __builtin_amdgcn_sched_barrier(0)
#define PG8_ABASE(u) ((const char*)g.A + (size_t)(u).pm * tstepA + (size_t)(u).kt0 * kstep + (g.grp_pn ? (size_t)((u).pn / g.grp_pn) * g.a_grp_bytes : (size_t)0))
#define PG8_BBASE(u) ((const char*)g.Bt + (size_t)(u).pn * tstep + (size_t)(u).kt0 * kstep)
    Unit cur, nxt; int ui = 0;
    if (!S.next(0, cur)) return;
    f32x4 acc[2][2][4][2];
#pragma unroll
    for (int a = 0; a < 2; ++a)
#pragma unroll
        for (int b = 0; b < 2; ++b)
#pragma unroll
            for (int m = 0; m < 4; ++m)
#pragma unroll
                for (int n = 0; n < 2; ++n) acc[a][b][m][n] = (f32x4){0.f, 0.f, 0.f, 0.f};
    bf16x8 At[4][2], B0[2][2], B1[2][2];
    const char* cA = PG8_ABASE(cur); const char* cB = PG8_BBASE(cur); int nt = cur.nkt;
    PG8_STAGE(PG8_SB(0, 0), cB, voffB); PG8_STAGE(PG8_SB(0, 1), cB + hstep, voffB); PG8_STAGE(PG8_SA(0, 0), cA, voffA); PG8_STAGE(PG8_SA(0, 1), cA + hstepA, voffA);
    if (wr == 1) PG8_BAR;
    PG8_WAIT_V(2); PG8_BAR;
    PG8_STAGE(PG8_SB(1, 0), cB + kstep, voffB); PG8_STAGE(PG8_SA(1, 0), cA + kstep, voffA); PG8_STAGE(PG8_SB(1, 1), cB + hstep + kstep, voffB);
    PG8_WAIT_V(6); PG8_BAR;
    for (;;) {
        const bool has_next = S.next(ui + 1, nxt);
        const char* nA = has_next ? PG8_ABASE(nxt) : cA; const char* nB = has_next ? PG8_BBASE(nxt) : cB;
        for (int t = 0; t < nt; t += 2) {
            const bool last = (t == nt - 2);
            const char* a1 = cA + (size_t)(t + 1) * kstep;
            const char* a2 = last ? nA : cA + (size_t)(t + 2) * kstep; const char* b2 = last ? nB : cB + (size_t)(t + 2) * kstep;
            const char* a3 = a2 + kstep; const char* b3 = b2 + kstep;
            PG8_LDB(B0, 0, 0); PG8_LDB(B1, 0, 1); PG8_SCHED; PG8_LDA(At, 0, 0); PG8_STAGE(PG8_SA(1, 1), a1 + hstepA, voffA);
            PG8_WAIT_V(8); PG8_WAIT_L(0); PG8_BAR; PG8_MMA(0, 0, At, B0); PG8_MMA(0, 1, At, B1); PG8_BAR; PG8_SCHED;
            PG8_LDA(At, 0, 1); PG8_STAGE(PG8_SB(0, 0), b2, voffB); PG8_STAGE(PG8_SB(0, 1), b2 + hstep, voffB); PG8_STAGE(PG8_SA(0, 0), a2, voffA);
            PG8_WAIT_V(8); PG8_WAIT_L(0); PG8_BAR; PG8_MMA(1, 0, At, B0); PG8_MMA(1, 1, At, B1); PG8_BAR; PG8_SCHED;
            PG8_LDB(B0, 1, 0); PG8_LDB(B1, 1, 1); PG8_SCHED; PG8_LDA(At, 1, 0); PG8_STAGE(PG8_SA(0, 1), a2 + hstepA, voffA);
            PG8_WAIT_V(8); PG8_WAIT_L(0); PG8_BAR; PG8_MMA(0, 0, At, B0); PG8_MMA(0, 1, At, B1); PG8_BAR; PG8_SCHED;
            PG8_LDA(At, 1, 1); PG8_STAGE(PG8_SB(1, 0), b3, voffB); PG8_STAGE(PG8_SB(1, 1), b3 + hstep, voffB); PG8_STAGE(PG8_SA(1, 0), a3, voffA);
            PG8_WAIT_V(8); PG8_WAIT_L(0); PG8_BAR; PG8_MMA(1, 0, At, B0); PG8_MMA(1, 1, At, B1); PG8_BAR; PG8_SCHED;
        }
        if constexpr (ALIGN_EPI) { if (wr == 0) PG8_BAR; }
        __builtin_amdgcn_sched_barrier(0); asm volatile("s_nop 15\n\ts_nop 3"); __builtin_amdgcn_sched_barrier(0);
        E(acc, cur, wr, wc, fr, fq);
        if (!has_next) break;
#pragma unroll
        for (int a = 0; a < 2; ++a)
#pragma unroll
            for (int b = 0; b < 2; ++b)
#pragma unroll
                for (int m = 0; m < 4; ++m)
#pragma unroll
                    for (int n = 0; n < 2; ++n) acc[a][b][m][n] = (f32x4){0.f, 0.f, 0.f, 0.f};
        cur = nxt; cA = nA; cB = nB; nt = cur.nkt; ++ui;
        if constexpr (ALIGN_EPI) { if (wr == 1) PG8_BAR; }
    }
    PG8_WAIT_V(0);
    if constexpr (!ALIGN_EPI) { if (wr == 0) PG8_BAR; }
    PG8_BAR;
#undef PG8_SA
#undef PG8_SB
#undef PG8_STAGE
#undef PG8_LDA
#undef PG8_LDB
#undef PG8_MMA
#undef PG8_WAIT_V
#undef PG8_WAIT_L
#undef PG8_BAR
#undef PG8_SCHED
#undef PG8_ABASE
#undef PG8_BBASE
}
}

typedef __bf16 bf16x2_t __attribute__((ext_vector_type(2)));
__device__ __forceinline__ unsigned pk2(float lo, float hi) { const f32x2 v = {lo, hi}; const bf16x2_t b = __builtin_convertvector(v, bf16x2_t); return __builtin_bit_cast(unsigned, b); }
__device__ __forceinline__ unsigned f2bf(float f) { return pk2(f, f) & 0xffffu; }
__device__ __forceinline__ float bflo(unsigned w) { return __builtin_bit_cast(float, w << 16); }
__device__ __forceinline__ float bfhi(unsigned w) { return __builtin_bit_cast(float, w & 0xffff0000u); }
__device__ __forceinline__ float bf1(bf16_t v) { return __builtin_bit_cast(float, (unsigned)v << 16); }
__device__ __forceinline__ float sigmoidf_(float v) { return 1.0f / (1.0f + __expf(-v)); }
__device__ __forceinline__ float siluf_(float v) { return v / (1.0f + __expf(-v)); }
__device__ __forceinline__ float sigmoid_fast(float v) { return __builtin_amdgcn_rcpf(1.0f + __expf(-v)); }
__device__ __forceinline__ float silu_fast(float v) { return v * __builtin_amdgcn_rcpf(1.0f + __expf(-v)); }
__device__ __forceinline__ float softplusf_(float v) { return v > 20.f ? v : log1pf(__expf(v)); }
__device__ __forceinline__ float wave_sum(float v) {
#pragma unroll
    for (int o = 1; o < 64; o <<= 1) v += __shfl_xor(v, o);
    return v;
}
__device__ __forceinline__ int rowb(int m) { return m < MP ? (m >> 11) : 4 + ((m - MP) >> 2); }
#define LDS_WAIT() asm volatile("s_waitcnt lgkmcnt(0)" ::: "memory")
#define MFMA_SETTLE4(a, b, c, d) do { __builtin_amdgcn_sched_barrier(0); asm volatile("s_nop 15\n\ts_nop 3"); __builtin_amdgcn_sched_barrier(0); } while (0)
#define MFMA_SETTLE1(a) MFMA_SETTLE4(a, a, a, a)

using pg8::Unit; using pg8::HALF; using pg8::BM; using pg8::cvt_pk_bf16;
__device__ __forceinline__ void acc4(float* p, const f32x4 v) { *(f32x4*)p = *(const f32x4*)p + v; }
struct EpiMods { static constexpr bool PERM = false; float* O;
    __device__ __forceinline__ void operator()(const f32x4 (&acc)[2][2][4][2], const Unit& u, int wr, int wc, int fr, int fq) const {
        const int col0 = u.pn * BM + wc * 32 + 4 * fq;
#pragma unroll
        for (int ai = 0; ai < 2; ++ai)
#pragma unroll
            for (int m = 0; m < 4; ++m) { const int r = u.pm * BM + ai * HALF + wr * 64 + m * 16 + fr; if (r >= 132) continue;
#pragma unroll
                for (int bj = 0; bj < 2; ++bj)
#pragma unroll
                    for (int n = 0; n < 2; ++n) acc4(O + (size_t)r * NMOD + col0 + bj * HALF + n * 16, acc[ai][bj][m][n]); }
    }
};
struct EpiSwiglu { static constexpr bool PERM = true; bf16_t* O;
    __device__ __forceinline__ void operator()(const f32x4 (&acc)[2][2][4][2], const Unit& u, int wr, int wc, int fr, int fq) const {
        const int col0 = u.pn * HALF + wc * 32 + 8 * fq;
#pragma unroll
        for (int ai = 0; ai < 2; ++ai)
#pragma unroll
            for (int m = 0; m < 4; ++m) { const int r = u.pm * BM + ai * HALF + wr * 64 + m * 16 + fr;
                float o[8];
#pragma unroll
                for (int n = 0; n < 2; ++n)
#pragma unroll
                    for (int v = 0; v < 4; ++v) o[4 * n + v] = silu_fast(acc[ai][0][m][n][v]) * acc[ai][1][m][n][v];
                u32x4 w; w.x = cvt_pk_bf16(o[0], o[1]); w.y = cvt_pk_bf16(o[2], o[3]); w.z = cvt_pk_bf16(o[4], o[5]); w.w = cvt_pk_bf16(o[6], o[7]);
                *(u32x4*)(O + (size_t)r * DFF + col0) = w; }
    }
};
struct EpiResid { static constexpr bool PERM = false; float* out; const float* gate; float coef; float* part; const float* base_p; const float* base_s;
    __device__ __forceinline__ void operator()(const f32x4 (&acc)[2][2][4][2], const Unit& u, int wr, int wc, int fr, int fq) const {
        const int col0 = u.pn * BM + wc * 32 + 4 * fq;
#pragma unroll
        for (int ai = 0; ai < 2; ++ai)
#pragma unroll
            for (int m = 0; m < 4; ++m) { const int r = u.pm * BM + ai * HALF + wr * 64 + m * 16 + fr;
                const float* grow = gate + (size_t)rowb(r) * NMOD; float* orow = out + (size_t)r * DM; const float* brow = base_p ? (r < MP ? base_p + (size_t)r * DM : base_s + (size_t)(r - MP) * DM) : orow; bf16_t* prow = (bf16_t*)part + (size_t)u.slot * 65536 + (size_t)(r & 255) * 256 - u.pn * BM;
#pragma unroll
                for (int bj = 0; bj < 2; ++bj)
#pragma unroll
                    for (int n = 0; n < 2; ++n) { const int c = col0 + bj * HALF + n * 16;
                        const f32x4 gv = *(const f32x4*)(grow + c); const f32x4 inc = coef * gv * acc[ai][bj][m][n];
                        if (u.atomic) { u32x2 pw; pw.x = pk2(inc.x, inc.y); pw.y = pk2(inc.z, inc.w); *(u32x2*)(prow + c) = pw; } else *(f32x4*)(orow + c) = *(const f32x4*)(brow + c) + inc; } }
    }
};
struct EpiProj { static constexpr bool PERM = true; bf16_t* O; float* dtraw;
    __device__ __forceinline__ void operator()(const f32x4 (&acc)[2][2][4][2], const Unit& u, int wr, int wc, int fr, int fq) const {
        const int col0 = u.pn * BM + wc * 32 + 8 * fq;
        const bool dtt = (u.pn == PC_DT / BM) && (wc < 2);
        const bool zt = (u.pn >= PC_Z / BM) && (u.pn < PC_XBC / BM);
#pragma unroll
        for (int ai = 0; ai < 2; ++ai)
#pragma unroll
            for (int m = 0; m < 4; ++m) { const int r = u.pm * BM + ai * HALF + wr * 64 + m * 16 + fr;
#pragma unroll
                for (int bj = 0; bj < 2; ++bj) { f32x4 v0 = acc[ai][bj][m][0], v1 = acc[ai][bj][m][1];
                    if (zt) { v0[0] = siluf_(v0[0]); v0[1] = siluf_(v0[1]); v0[2] = siluf_(v0[2]); v0[3] = siluf_(v0[3]); v1[0] = siluf_(v1[0]); v1[1] = siluf_(v1[1]); v1[2] = siluf_(v1[2]); v1[3] = siluf_(v1[3]); }
                    u32x4 w; w.x = cvt_pk_bf16(v0[0], v0[1]); w.y = cvt_pk_bf16(v0[2], v0[3]); w.z = cvt_pk_bf16(v1[0], v1[1]); w.w = cvt_pk_bf16(v1[2], v1[3]);
                    *(u32x4*)(O + (size_t)r * DPROJP + col0 + bj * HALF) = w;
                    if (bj == 0 && dtt) { float* d = dtraw + (size_t)r * 64 + wc * 32 + 8 * fq; *(f32x4*)d = v0; *(f32x4*)(d + 4) = v1; } } }
    }
};
struct EpiPlain { static constexpr bool PERM = true; bf16_t* O;
    __device__ __forceinline__ void operator()(const f32x4 (&acc)[2][2][4][2], const Unit& u, int wr, int wc, int fr, int fq) const {
        const int col0 = u.pn * BM + wc * 32 + 8 * fq;
#pragma unroll
        for (int bj = 0; bj < 2; ++bj)
#pragma unroll
            for (int ai = 0; ai < 2; ++ai)
#pragma unroll
                for (int m = 0; m < 4; ++m) { const int r = u.pm * BM + ai * HALF + wr * 64 + m * 16 + fr;
                    const f32x4 v0 = acc[ai][bj][m][0], v1 = acc[ai][bj][m][1];
                    u32x4 w; w.x = cvt_pk_bf16(v0[0], v0[1]); w.y = cvt_pk_bf16(v0[2], v0[3]); w.z = cvt_pk_bf16(v1[0], v1[1]); w.w = cvt_pk_bf16(v1[2], v1[3]);
                    *(u32x4*)(O + (size_t)r * DM + col0 + bj * HALF) = w; }
    }
};
struct EpiScale { static constexpr bool PERM = true; bf16_t* O; const float* scale;
    __device__ __forceinline__ void operator()(const f32x4 (&acc)[2][2][4][2], const Unit& u, int wr, int wc, int fr, int fq) const {
        const int col0 = u.pn * BM + wc * 32 + 8 * fq;
#pragma unroll
        for (int bj = 0; bj < 2; ++bj) { const f32x4 s0 = *(const f32x4*)(scale + col0 + bj * HALF), s1 = *(const f32x4*)(scale + col0 + bj * HALF + 4);
#pragma unroll
            for (int ai = 0; ai < 2; ++ai)
#pragma unroll
                for (int m = 0; m < 4; ++m) { const int r = u.pm * BM + ai * HALF + wr * 64 + m * 16 + fr;
                    const f32x4 v0 = acc[ai][bj][m][0] * s0, v1 = acc[ai][bj][m][1] * s1;
                    u32x4 w; w.x = cvt_pk_bf16(v0[0], v0[1]); w.y = cvt_pk_bf16(v0[2], v0[3]); w.z = cvt_pk_bf16(v1[0], v1[1]); w.w = cvt_pk_bf16(v1[2], v1[3]);
                    *(u32x4*)(O + (size_t)r * DM + col0 + bj * HALF) = w; } }
    }
};
template <bool MERGE> struct EpiGate { static constexpr bool PERM = true; const bf16_t* proj; int gcol; float* tmp; bf16_t* merged; float* part;
    __device__ __forceinline__ void operator()(const f32x4 (&acc)[2][2][4][2], const Unit& u, int wr, int wc, int fr, int fq) const {
        const int col0 = u.pn * BM + wc * 32 + 8 * fq;
#pragma unroll
        for (int ai = 0; ai < 2; ++ai)
#pragma unroll
            for (int m = 0; m < 4; ++m) { const int r = u.pm * BM + ai * HALF + wr * 64 + m * 16 + fr;
#pragma unroll
                for (int bj = 0; bj < 2; ++bj) { const int c = col0 + bj * HALF;
                    const u32x4 gw = *(const u32x4*)(proj + (size_t)r * DPROJP + gcol + c);
                    f32x4 v0 = acc[ai][bj][m][0], v1 = acc[ai][bj][m][1];
                    v0[0] *= sigmoid_fast(bflo(gw.x)); v0[1] *= sigmoid_fast(bfhi(gw.x)); v0[2] *= sigmoid_fast(bflo(gw.y)); v0[3] *= sigmoid_fast(bfhi(gw.y));
                    v1[0] *= sigmoid_fast(bflo(gw.z)); v1[1] *= sigmoid_fast(bfhi(gw.z)); v1[2] *= sigmoid_fast(bflo(gw.w)); v1[3] *= sigmoid_fast(bfhi(gw.w));
                    float* tp = tmp + (size_t)r * DM + c;
                    if (u.atomic) { bf16_t* pp = (bf16_t*)part + (size_t)u.slot * 65536 + (size_t)(r & 255) * 256 + (c - u.pn * BM); u32x4 pw; pw.x = pk2(v0[0], v0[1]); pw.y = pk2(v0[2], v0[3]); pw.z = pk2(v1[0], v1[1]); pw.w = pk2(v1[2], v1[3]); *(u32x4*)pp = pw; }
                    else if constexpr (!MERGE) { *(f32x4*)tp = v0; *(f32x4*)(tp + 4) = v1; }
                    else { v0 += *(const f32x4*)tp; v1 += *(const f32x4*)(tp + 4);
                        u32x4 w; w.x = cvt_pk_bf16(v0[0], v0[1]); w.y = cvt_pk_bf16(v0[2], v0[3]); w.z = cvt_pk_bf16(v1[0], v1[1]); w.w = cvt_pk_bf16(v1[2], v1[3]);
                        *(u32x4*)(merged + (size_t)r * DM + c) = w; } } }
    }
};

struct Args { const float* in[29]; float* out; unsigned char* ws; int ph_lo, ph_hi, coop, pad; };
struct Ctx { LAS unsigned char* lds; int tid, lane, wave, G, bid; };

struct TItem { const float* src; bf16_t* dst; int N, K; };
__device__ __forceinline__ int rm_swiglu(int n0) { return n0 < DFF ? (n0 >> 7) * 256 + (n0 & 127) : ((n0 - DFF) >> 7) * 256 + 128 + ((n0 - DFF) & 127); }
__device__ __forceinline__ TItem titem(const float* W, int K, int N, bf16_t* WT, int item, int row_off, bool swiglu) {
    const int nblk = N / 32, kb = item / nblk, nb = item % nblk, k0 = 64 * kb, n0 = 32 * nb;
    TItem t; t.src = W + (size_t)k0 * N + n0; t.dst = WT + (size_t)(swiglu ? rm_swiglu(n0) : row_off + n0) * K + k0; t.N = N; t.K = K; return t;
}
__device__ __forceinline__ TItem p0_decode(const Args& a, int r) {
    unsigned char* ws = a.ws;
    constexpr int I_ADA = 32 * (NMOD / 32), I_13 = 32 * (2 * DFF / 32), I_2 = (DFF / 64) * (DM / 32), I_IN = 32 * (DPROJ / 32), I_PW = 8 * 16, I_BP = 32 * 64, I_BS = 64 * 64;
    if (r < I_ADA) return titem(a.in[7], DM, NMOD, (bf16_t*)(ws + WS_WADA), r, 0, false); r -= I_ADA;
    if (r < I_13) return titem(a.in[10], DM, 2 * DFF, (bf16_t*)(ws + WS_W13A), r, 0, true); r -= I_13;
    if (r < I_2) return titem(a.in[11], DFF, DM, (bf16_t*)(ws + WS_W2A), r, 0, false); r -= I_2;
    if (r < I_IN) return titem(a.in[13], DM, DPROJ, (bf16_t*)(ws + WS_WIN), r, 0, false); r -= I_IN;
    if (r < 4 * I_PW) { const int g = r / I_PW; return titem(a.in[14] + (size_t)g * 512 * 512, 512, 512, (bf16_t*)(ws + WS_YPOOL + 16 * MiB), r % I_PW, g * 512, false); } r -= 4 * I_PW;
    if (r < I_BP) return titem(a.in[22], DM, DM, (bf16_t*)(ws + WS_WBP), r, 0, false); r -= I_BP;
    if (r < I_BS) return titem(a.in[23], DIN, DM, (bf16_t*)(ws + WS_WBS), r, 0, false); r -= I_BS;
    if (r < I_BP) return titem(a.in[24], DM, DM, (bf16_t*)(ws + WS_WOUT), r, 0, false); r -= I_BP;
    if (r < I_13) return titem(a.in[26], DM, 2 * DFF, (bf16_t*)(ws + WS_W13B), r, 0, true); r -= I_13;
    return titem(a.in[27], DFF, DM, (bf16_t*)(ws + WS_W2B), r, 0, false);
}
constexpr int P0_I_ADA = 32 * (NMOD / 32), P0_I_13 = 32 * (2 * DFF / 32), P0_I_2 = (DFF / 64) * (DM / 32), P0_I_IN = 32 * (DPROJ / 32), P0_I_PW = 8 * 16, P0_I_BP = 32 * 64, P0_I_BS = 64 * 64;
constexpr int P0_NITEMS = P0_I_ADA + 2 * P0_I_13 + 2 * P0_I_2 + P0_I_IN + 4 * P0_I_PW + 2 * P0_I_BP + P0_I_BS;
constexpr int P0_EARLY = P0_NITEMS - P0_I_13 - P0_I_2;
constexpr int P0_DEFER_A = P0_EARLY + 4608;
__device__ __forceinline__ void convert_range(const Ctx& F, const Args& a, int it0, int it_end, int stride, int skip_lo = 1 << 30, int skip_len = 0) {
    LAS float* scr = (LAS float*)(F.lds + F.wave * 16384);
    const int lane = F.lane, lr = lane >> 3, lc = 4 * (lane & 7);
    int it = it0;
    f32x4 R[8]; TItem cur;
#define P0_LOAD(T, RR) do { _Pragma("unroll") for (int i = 0; i < 8; ++i) RR[i] = __builtin_nontemporal_load((const f32x4*)((T).src + (size_t)(8 * i + lr) * (T).N + lc)); } while (0)
    if (it < it_end) { cur = p0_decode(a, it >= skip_lo ? it + skip_len : it); P0_LOAD(cur, R); }
    while (it < it_end) {
        const int nit = it + stride; f32x4 Rn[8]; TItem nxt = cur;
        if (nit < it_end) { nxt = p0_decode(a, nit >= skip_lo ? nit + skip_len : nit); P0_LOAD(nxt, Rn); }
#pragma unroll
        for (int i = 0; i < 8; ++i) { LAS float* q = scr + (8 * i + lr) * 33 + lc; q[0] = R[i].x; q[1] = R[i].y; q[2] = R[i].z; q[3] = R[i].w; }
        LDS_WAIT(); asm volatile("" ::: "memory");
        { const int c = lane & 7;
#pragma unroll
          for (int j = 0; j < 4; ++j) { const int n = (lane >> 3) + 8 * j; const LAS float* q = scr + (8 * c) * 33 + n;
              u32x4 o; o.x = pk2(q[0 * 33], q[1 * 33]); o.y = pk2(q[2 * 33], q[3 * 33]); o.z = pk2(q[4 * 33], q[5 * 33]); o.w = pk2(q[6 * 33], q[7 * 33]);
              *(u32x4*)(cur.dst + (size_t)n * cur.K + 8 * c) = o; } }
        LDS_WAIT(); asm volatile("" ::: "memory");
#pragma unroll
        for (int i = 0; i < 8; ++i) R[i] = Rn[i];
        cur = nxt; it = nit;
    }
#undef P0_LOAD
}
__device__ __forceinline__ void p0_prologue(const Ctx& F, const Args& a, int part, int wg0, int nwg) {
    unsigned char* ws = a.ws;
    const int gw = (F.bid - wg0) * 8 + F.wave, NGW = nwg * 8;
    constexpr int BP_LO = P0_I_ADA + P0_I_13 + P0_I_2 + P0_I_IN + 4 * P0_I_PW;
    if (part == 0) { convert_range(F, a, gw, P0_I_ADA, NGW); convert_range(F, a, BP_LO + gw, BP_LO + P0_I_BP, NGW); }
    else convert_range(F, a, gw + P0_I_ADA, P0_EARLY - P0_I_BP, NGW, BP_LO, P0_I_BP);
    if (part != 0) return;
    { u32x4* z = (u32x4*)((bf16_t*)(ws + WS_WIN) + (size_t)DPROJ * DM); const int n16 = (DPROJP - DPROJ) * DM * 2 / 16;
      for (int i = F.bid * 512 + F.tid; i < n16; i += F.G * 512) z[i] = (u32x4){0u, 0u, 0u, 0u}; }
    { bf16_t* pws = (bf16_t*)(ws + WS_WPOOL); for (int i = F.bid * 512 + F.tid; i < 4 * 512 * 512 / 4; i += F.G * 512) { const int e = i * 4, cc = e >> 9, d = e & 511;
        const f32x4 w4 = *(const f32x4*)(a.in[14] + e), s4 = *(const f32x4*)(a.in[15] + (cc >> 9) * 512 + d); u32x2 o; o.x = pk2(w4.x * s4.x, w4.y * s4.y); o.y = pk2(w4.z * s4.z, w4.w * s4.w); *(u32x2*)(pws + e) = o; } }
    { float* mods = (float*)(ws + WS_MODS); for (int i = F.bid * 512 + F.tid; i < 132 * NMOD / 4; i += F.G * 512) { const int c = (i % (NMOD / 4)) * 4; *(f32x4*)(mods + (size_t)(i / (NMOD / 4)) * NMOD + c) = *(const f32x4*)(a.in[8] + c); } }
    { bf16_t* Ac = (bf16_t*)(ws + WS_AC);
      for (int i = F.bid * 512 + F.tid; i < 256 * DM / 2; i += F.G * 512) { const int r = i / (DM / 2), c = (i % (DM / 2)) * 2;
          unsigned w = 0u;
          if (r < 132) { const float* src = r < 4 ? a.in[2] + (size_t)r * DM : a.in[3] + (size_t)(r - 4) * DM; w = pk2(siluf_(src[c]), siluf_(src[c + 1])); }
          *(unsigned*)(Ac + (size_t)r * DM + c) = w; } }
}

__device__ __forceinline__ void norm_mod_rows(const Ctx& F, const float* xp, const float* xs, const float* gamma, const float* mods, int sh_off, int sc_off, bf16_t* out, const float* fixb_p, const float* fixb_s, const float* part, int S, const LAS int* tmap) {
    const int gw = F.bid * 8 + F.wave, NGW = F.G * 8;
    f32x4 gm[8];
#pragma unroll
    for (int j = 0; j < 8; ++j) gm[j] = *(const f32x4*)(gamma + 4 * F.lane + 256 * j);
    for (int m = gw; m < MT; m += NGW) {
        float* xrow = (float*)((m < MP) ? xp + (size_t)m * DM : xs + (size_t)(m - MP) * DM);
        const f32x4* xr = (const f32x4*)xrow + F.lane;
        f32x4 v[8]; float s = 0.f;
#pragma unroll
        for (int j = 0; j < 8; ++j) v[j] = xr[64 * j];
        if (S > 1) {
#pragma unroll
            for (int j = 0; j < 8; ++j) { const int un = tmap[(m >> 8) * 8 + j]; if (un >= 0) { f32x4 q = (f32x4){0.f, 0.f, 0.f, 0.f};
                const bf16_t* pb_ = (const bf16_t*)part + (size_t)(un * S) * 65536 + (m & 255) * 256 + 4 * F.lane;
                if (S == 16) {
                    u32x2 pw[16];
#pragma unroll
                    for (int pc = 0; pc < 16; ++pc) pw[pc] = *(const u32x2*)(pb_ + (size_t)pc * 65536);
#pragma unroll
                    for (int pc = 0; pc < 16; ++pc) q += (f32x4){bflo(pw[pc].x), bfhi(pw[pc].x), bflo(pw[pc].y), bfhi(pw[pc].y)};
                } else for (int pc = 0; pc < S; ++pc) { const u32x2 pw = *(const u32x2*)(pb_ + (size_t)pc * 65536); q += (f32x4){bflo(pw.x), bfhi(pw.x), bflo(pw.y), bfhi(pw.y)}; }
                if (fixb_p) v[j] = ((const f32x4*)((m < MP) ? fixb_p + (size_t)m * DM : fixb_s + (size_t)(m - MP) * DM))[F.lane + 64 * j];
                v[j] += q; ((f32x4*)xrow)[F.lane + 64 * j] = v[j]; } } }
        const float* mr = mods + (size_t)rowb(m) * NMOD;
        f32x4 scv[8], shv[8];
#pragma unroll
        for (int j = 0; j < 8; ++j) { const int c = 4 * F.lane + 256 * j; scv[j] = *(const f32x4*)(mr + sc_off + c); shv[j] = *(const f32x4*)(mr + sh_off + c); }
#pragma unroll
        for (int j = 0; j < 8; ++j) s += (v[j].x * v[j].x + v[j].y * v[j].y) + (v[j].z * v[j].z + v[j].w * v[j].w);
        const float rinv = 1.0f / sqrtf(wave_sum(s) * (1.0f / DM) + EPS);
        u32x2* o8 = (u32x2*)(out + (size_t)m * DM) + F.lane;
#pragma unroll
        for (int j = 0; j < 8; ++j) {
            const f32x4 y = (v[j] * rinv * gm[j]) * (1.0f + scv[j]) + shv[j];
            u32x2 w; w.x = pk2(y.x, y.y); w.y = pk2(y.z, y.w); o8[64 * j] = w; }
    }
}
__device__ __forceinline__ void final_norm_rows(const Ctx& F, const float* h, const float* gamma, float* out, const float* part, int S, const LAS int* tmap) {
    const int gw = F.bid * 8 + F.wave, NGW = F.G * 8;
    f32x4 gm[8];
#pragma unroll
    for (int j = 0; j < 8; ++j) gm[j] = *(const f32x4*)(gamma + 4 * F.lane + 256 * j);
    for (int m = gw; m < MT; m += NGW) {
        const f32x4* xr = (const f32x4*)(h + (size_t)m * DM) + F.lane;
        f32x4 v[8]; float s = 0.f;
#pragma unroll
        for (int j = 0; j < 8; ++j) v[j] = xr[64 * j];
        if (S > 1) {
#pragma unroll
            for (int j = 0; j < 8; ++j) { const int un = tmap[(m >> 8) * 8 + j]; if (un >= 0) { f32x4 q = (f32x4){0.f, 0.f, 0.f, 0.f};
                const bf16_t* pb_ = (const bf16_t*)part + (size_t)(un * S) * 65536 + (m & 255) * 256 + 4 * F.lane;
                if (S == 16) {
                    u32x2 pw[16];
#pragma unroll
                    for (int pc = 0; pc < 16; ++pc) pw[pc] = *(const u32x2*)(pb_ + (size_t)pc * 65536);
#pragma unroll
                    for (int pc = 0; pc < 16; ++pc) q += (f32x4){bflo(pw[pc].x), bfhi(pw[pc].x), bflo(pw[pc].y), bfhi(pw[pc].y)};
                } else for (int pc = 0; pc < S; ++pc) { const u32x2 pw = *(const u32x2*)(pb_ + (size_t)pc * 65536); q += (f32x4){bflo(pw.x), bfhi(pw.x), bflo(pw.y), bfhi(pw.y)}; }
                v[j] += q; } } }
#pragma unroll
        for (int j = 0; j < 8; ++j) s += (v[j].x * v[j].x + v[j].y * v[j].y) + (v[j].z * v[j].z + v[j].w * v[j].w);
        const float rinv = 1.0f / sqrtf(wave_sum(s) * (1.0f / DM) + EPS);
        f32x4* o = (f32x4*)(out + (size_t)m * DM) + F.lane;
#pragma unroll
        for (int j = 0; j < 8; ++j) o[64 * j] = v[j] * rinv * gm[j];
    }
}

constexpr int SP = 272;
constexpr int SC_XT = 0, SC_BN = 34816, SC_WM = 69632, SC_HB = 104448, SC_S = 139264, SC_DT = SC_S + 512, SC_W = SC_S + 1024, SC_E = SC_S + 1536, SC_END = SC_S + 2048;
static_assert(SC_END <= LDS_BYTES - 64, "scan LDS map");

template <int W> __device__ __forceinline__ void pool_prompt_run(const bf16_t* U, bf16_t* P, float* OPp, int t0) {
    u32x2 r[W - 1 + 16];
#pragma unroll
    for (int i = 0; i < W - 1 + 16; ++i) { const int row = t0 - (W - 1) + i; r[i] = row >= 0 ? *(const u32x2*)(U + (ptrdiff_t)row * DPROJP) : (u32x2){0u, 0u}; }
    float s0 = 0.f, s1 = 0.f, s2 = 0.f, s3 = 0.f;
#pragma unroll
    for (int i = 0; i < W - 1; ++i) { s0 += bflo(r[i].x); s1 += bfhi(r[i].x); s2 += bflo(r[i].y); s3 += bfhi(r[i].y); }
#pragma unroll
    for (int j = 0; j < 16; ++j) { const int t = t0 + j; const u32x2 q = r[W - 1 + j]; const float u0 = bflo(q.x), u1 = bfhi(q.x), u2 = bflo(q.y), u3 = bfhi(q.y);
        s0 += u0; s1 += u1; s2 += u2; s3 += u3;
        const float ic = 1.0f / (float)(t + 1 < W ? t + 1 : W);
        u32x2 o; o.x = pk2(s0 * ic - u0, s1 * ic - u1); o.y = pk2(s2 * ic - u2, s3 * ic - u3);
        *(u32x2*)(P + (size_t)t * DM) = o;
        s0 -= bflo(r[j].x); s1 -= bfhi(r[j].x); s2 -= bflo(r[j].y); s3 -= bfhi(r[j].y);
        if (t >= SEQ - 15) *(f32x4*)(OPp + (size_t)(t - (SEQ - 15)) * DM) = (f32x4){u0, u1, u2, u3}; }
}
__device__ __forceinline__ void pool_prompt_item(const Ctx& F, int item, const bf16_t* proj, bf16_t* pooled, float* out) {
    const int b = item >> 7, t0 = (item & 127) * 16, c0 = 4 * F.tid, g = F.tid >> 7;
    const bf16_t* U = proj + (size_t)b * SEQ * DPROJP + PC_POOL + c0;
    bf16_t* P = pooled + (size_t)b * SEQ * DM + c0;
    float* OPp = out + O_PPOOL + (size_t)b * 15 * DM + c0;
    if (g == 0) pool_prompt_run<2>(U, P, OPp, t0); else if (g == 1) pool_prompt_run<4>(U, P, OPp, t0); else if (g == 2) pool_prompt_run<8>(U, P, OPp, t0); else pool_prompt_run<16>(U, P, OPp, t0);
}
template <int W> __device__ __forceinline__ void pool_sample_run(const bf16_t* U, const float* SPp, bf16_t* P, float* OP) {
    f32x4 f[19];
#pragma unroll
    for (int r = 0; r < 15; ++r) f[r] = *(const f32x4*)(SPp + (size_t)r * DM);
#pragma unroll
    for (int t = 0; t < 4; ++t) { const u32x2 q = *(const u32x2*)(U + (size_t)t * DPROJP); f[15 + t] = (f32x4){bflo(q.x), bfhi(q.x), bflo(q.y), bfhi(q.y)}; }
    f32x4 s = (f32x4){0.f, 0.f, 0.f, 0.f};
#pragma unroll
    for (int r = 15 - W + 1; r < 15; ++r) s += f[r];
#pragma unroll
    for (int t = 0; t < 4; ++t) { s += f[15 + t]; const f32x4 pv = s * (1.0f / (float)W) - f[15 + t];
        u32x2 o; o.x = pk2(pv.x, pv.y); o.y = pk2(pv.z, pv.w); *(u32x2*)(P + (size_t)t * DM) = o; s -= f[15 + t - W + 1]; }
#pragma unroll
    for (int r = 4; r < 19; ++r) *(f32x4*)(OP + (size_t)(r - 4) * DM) = f[r];
}
__device__ __forceinline__ void pool_sample_item(const Ctx& F, int bb, const bf16_t* proj, const float* spool, bf16_t* pooled, float* out) {
    const int c0 = 4 * F.tid, g = F.tid >> 7;
    const bf16_t* U = proj + (size_t)(MP + 4 * bb) * DPROJP + PC_POOL + c0;
    const float* SPp = spool + (size_t)bb * 15 * DM + c0;
    bf16_t* P = pooled + (size_t)(MP + 4 * bb) * DM + c0;
    float* OP = out + O_SPOOL + (size_t)bb * 15 * DM + c0;
    if (g == 0) pool_sample_run<2>(U, SPp, P, OP); else if (g == 1) pool_sample_run<4>(U, SPp, P, OP); else if (g == 2) pool_sample_run<8>(U, SPp, P, OP); else pool_sample_run<16>(U, SPp, P, OP);
}

__device__ __forceinline__ void prepass_phase(const Ctx& F, const Args& a) {
    unsigned char* ws = a.ws;
    const bf16_t* proj = (const bf16_t*)(ws + WS_PROJ); bf16_t* xact = (bf16_t*)(ws + WS_XACT); float* dtv = (float*)(ws + WS_DTRAW); bf16_t* pooled = (bf16_t*)(ws + WS_POOLED);
    const float* cwt = a.in[16]; const float* cbs = a.in[17];
    const int gtid = F.bid * 512 + F.tid, NT = F.G * 512;
    for (int id = gtid; id < NB * 128 * 768; id += NT) {
        const int oc = id % 768, run = id / 768, b = run >> 7, t0 = (run & 127) * 16, ch = oc * 8;
        const bf16_t* src = proj + (size_t)(b * SEQ + t0) * DPROJP + PC_XBC + ch;
        u32x4 r[19];
#pragma unroll
        for (int i = 0; i < 19; ++i) r[i] = (t0 - 3 + i >= 0) ? *(const u32x4*)(src + (ptrdiff_t)(i - 3) * DPROJP) : (u32x4){0u, 0u, 0u, 0u};
        f32x4 w[4][2], bs[2];
#pragma unroll
        for (int k = 0; k < 4; ++k) { w[k][0] = *(const f32x4*)(cwt + (size_t)k * CONVD + ch); w[k][1] = *(const f32x4*)(cwt + (size_t)k * CONVD + ch + 4); }
        bs[0] = *(const f32x4*)(cbs + ch); bs[1] = *(const f32x4*)(cbs + ch + 4);
        bf16_t* dst = xact + (size_t)(b * SEQ + t0) * CONVD + ch;
#pragma unroll
        for (int j = 0; j < 16; ++j) { f32x4 o0 = bs[0], o1 = bs[1];
#pragma unroll
            for (int k = 0; k < 4; ++k) { const u32x4 q = r[j + k];
                o0 += w[k][0] * (f32x4){bflo(q.x), bfhi(q.x), bflo(q.y), bfhi(q.y)}; o1 += w[k][1] * (f32x4){bflo(q.z), bfhi(q.z), bflo(q.w), bfhi(q.w)}; }
            u32x4 pw; pw.x = pk2(siluf_(o0.x), siluf_(o0.y)); pw.y = pk2(siluf_(o0.z), siluf_(o0.w)); pw.z = pk2(siluf_(o1.x), siluf_(o1.y)); pw.w = pk2(siluf_(o1.z), siluf_(o1.w));
            *(u32x4*)(dst + (size_t)j * CONVD) = pw; }
        if (t0 == SEQ - 16) {
#pragma unroll
            for (int jj = 0; jj < 3; ++jj) { const u32x4 q = r[16 + jj]; float* o = a.out + O_PCONV + ((size_t)b * 3 + jj) * CONVD + ch;
                *(f32x4*)o = (f32x4){bflo(q.x), bfhi(q.x), bflo(q.y), bfhi(q.y)}; *(f32x4*)(o + 4) = (f32x4){bflo(q.z), bfhi(q.z), bflo(q.w), bfhi(q.w)}; } }
    }
    for (int id = gtid; id < DB * 768; id += NT) {
        const int oc = id % 768, bb = id / 768, ch = oc * 8;
        f32x4 f[7][2];
#pragma unroll
        for (int r = 0; r < 3; ++r) { const float* sp = a.in[5] + ((size_t)bb * 3 + r) * CONVD + ch; f[r][0] = *(const f32x4*)sp; f[r][1] = *(const f32x4*)(sp + 4); }
#pragma unroll
        for (int r = 0; r < 4; ++r) { const u32x4 q = *(const u32x4*)(proj + (size_t)(MP + 4 * bb + r) * DPROJP + PC_XBC + ch);
            f[3 + r][0] = (f32x4){bflo(q.x), bfhi(q.x), bflo(q.y), bfhi(q.y)}; f[3 + r][1] = (f32x4){bflo(q.z), bfhi(q.z), bflo(q.w), bfhi(q.w)}; }
        f32x4 w[4][2], bs[2];
#pragma unroll
        for (int k = 0; k < 4; ++k) { w[k][0] = *(const f32x4*)(cwt + (size_t)k * CONVD + ch); w[k][1] = *(const f32x4*)(cwt + (size_t)k * CONVD + ch + 4); }
        bs[0] = *(const f32x4*)(cbs + ch); bs[1] = *(const f32x4*)(cbs + ch + 4);
#pragma unroll
        for (int t = 0; t < 4; ++t) { f32x4 o0 = bs[0], o1 = bs[1];
#pragma unroll
            for (int k = 0; k < 4; ++k) { o0 += w[k][0] * f[t + k][0]; o1 += w[k][1] * f[t + k][1]; }
            u32x4 pw; pw.x = pk2(siluf_(o0.x), siluf_(o0.y)); pw.y = pk2(siluf_(o0.z), siluf_(o0.w)); pw.z = pk2(siluf_(o1.x), siluf_(o1.y)); pw.w = pk2(siluf_(o1.z), siluf_(o1.w));
            *(u32x4*)(xact + (size_t)(MP + 4 * bb + t) * CONVD + ch) = pw; }
#pragma unroll
        for (int jj = 0; jj < 3; ++jj) { float* o = a.out + O_SCONV + ((size_t)bb * 3 + jj) * CONVD + ch; *(f32x4*)o = f[4 + jj][0]; *(f32x4*)(o + 4) = f[4 + jj][1]; }
    }
    for (int id = gtid; id < MT * 64 / 4; id += NT) { f32x4 v = *(const f32x4*)(dtv + (size_t)id * 4); const f32x4 bb4 = *(const f32x4*)(a.in[18] + (id & 15) * 4);
        v.x = softplusf_(v.x + bb4.x); v.y = softplusf_(v.y + bb4.y); v.z = softplusf_(v.z + bb4.z); v.w = softplusf_(v.w + bb4.w); *(f32x4*)(dtv + (size_t)id * 4) = v; }
    for (int it = F.bid; it < NB * 128; it += F.G) pool_prompt_item(F, it, proj, pooled, a.out);
    for (int it = F.bid; it < DB; it += F.G) pool_sample_item(F, it, proj, a.in[6], pooled, a.out);
}

__device__ __forceinline__ void scan_prompt_item(const Ctx& F, int b, int h, const Args& a, const bf16_t* proj, const bf16_t* xact, const float* dtv, bf16_t* ygated, float* ssq) {
    LAS unsigned char* L = F.lds;
    const int tid = F.tid, w = F.wave, lane = F.lane, fr = lane & 15, fq = lane >> 4, g = h >> 3;
    const float aneg = -__expf(a.in[19][h]), Dk = a.in[20][h];
    LAS float* sS = (LAS float*)(L + SC_S); LAS float* sDT = (LAS float*)(L + SC_DT); LAS float* sW = (LAS float*)(L + SC_W); LAS float* sE = (LAS float*)(L + SC_E);
    __syncthreads();
    for (int i = tid; i < 17408 / 4; i += 512) ((LAS unsigned*)(L + SC_HB))[i] = 0u;
    f32x4 hreg[4];
#pragma unroll
    for (int pt = 0; pt < 4; ++pt) hreg[pt] = (f32x4){0.f, 0.f, 0.f, 0.f};
    u32x4 px[2], pb[4], pc[4]; float pd0 = 0.f, pd1 = 0.f;
#define SCAN_LOAD(cc) do { const int m0_ = b * SEQ + (cc) * 128; \
        _Pragma("unroll") for (int i = 0; i < 2; ++i) { const int v = tid + 512 * i; px[i] = *(const u32x4*)(xact + (size_t)(m0_ + (v >> 3)) * CONVD + h * 64 + 8 * (v & 7)); } \
        _Pragma("unroll") for (int i = 0; i < 4; ++i) { const int v = tid + 512 * i; pb[i] = *(const u32x4*)(xact + (size_t)(m0_ + (v >> 4)) * CONVD + DIN + g * 128 + 8 * (v & 15)); } \
        _Pragma("unroll") for (int ks = 0; ks < 4; ++ks) pc[ks] = *(const u32x4*)(xact + (size_t)(m0_ + 16 * w + fr) * CONVD + DIN + 1024 + g * 128 + 32 * ks + 8 * fq); \
        if (w == 0) { pd0 = dtv[(size_t)(m0_ + 2 * lane) * 64 + h]; pd1 = dtv[(size_t)(m0_ + 2 * lane + 1) * 64 + h]; } } while (0)
    SCAN_LOAD(0);
    for (int c = 0; c < 16; ++c) {
        const int m0 = b * SEQ + c * 128;
        __syncthreads();
        u32x2 zr[4];
#pragma unroll
        for (int pt = 0; pt < 4; ++pt) zr[pt] = *(const u32x2*)(proj + (size_t)(m0 + 16 * w + fr) * DPROJP + PC_Z + h * 64 + 16 * pt + 4 * fq);
#pragma unroll
        for (int i = 0; i < 2; ++i) { const int v = tid + 512 * i, pg = v & 7, s_ = v >> 3; const unsigned q[4] = {px[i].x, px[i].y, px[i].z, px[i].w};
#pragma unroll
            for (int e = 0; e < 4; ++e) { *(LAS bf16_t*)(L + SC_XT + (8 * pg + 2 * e) * SP + s_ * 2) = (bf16_t)(q[e] & 0xffffu); *(LAS bf16_t*)(L + SC_XT + (8 * pg + 2 * e + 1) * SP + s_ * 2) = (bf16_t)(q[e] >> 16); } }
#pragma unroll
        for (int i = 0; i < 4; ++i) { const int v = tid + 512 * i; *(LAS u32x4*)(L + SC_BN + (v >> 4) * SP + (v & 15) * 16) = pb[i]; }
        bf16x8 Cf[4];
#pragma unroll
        for (int ks = 0; ks < 4; ++ks) Cf[ks] = __builtin_bit_cast(bf16x8, pc[ks]);
        if (w == 0) {
            const float d0 = pd0, d1 = pd1, l0 = d0 * aneg, l1 = d1 * aneg; float inc = l0 + l1;
#pragma unroll
            for (int o = 1; o < 64; o <<= 1) { const float v = __shfl_up(inc, o); if (lane >= o) inc += v; }
            const float s1 = inc, s0 = inc - l1, slast = __shfl(inc, 63);
            sS[2 * lane] = s0; sS[2 * lane + 1] = s1; sDT[2 * lane] = d0; sDT[2 * lane + 1] = d1;
            sW[2 * lane] = __expf(slast - s0) * d0; sW[2 * lane + 1] = __expf(slast - s1) * d1; sE[2 * lane] = __expf(s0); sE[2 * lane + 1] = __expf(s1);
        }
        if (c < 15) SCAN_LOAD(c + 1);
        __syncthreads();
        const float st = sS[16 * w + fr];
        for (int j = 0; j <= w; ++j) {
            f32x4 d = (f32x4){0.f, 0.f, 0.f, 0.f};
#pragma unroll
            for (int ks = 0; ks < 4; ++ks) { const bf16x8 bfr = *(const LAS bf16x8*)(L + SC_BN + (16 * j + fr) * SP + (32 * ks + 8 * fq) * 2); d = __builtin_amdgcn_mfma_f32_16x16x32_bf16(bfr, Cf[ks], d, 0, 0, 0); }
            MFMA_SETTLE1(d);
            const f32x4 ss4 = *(const LAS f32x4*)(sS + 16 * j + 4 * fq), dt4 = *(const LAS f32x4*)(sDT + 16 * j + 4 * fq);
            float wv[4];
#pragma unroll
            for (int v = 0; v < 4; ++v) { const int si = 16 * j + 4 * fq + v; wv[v] = (si <= 16 * w + fr) ? d[v] * __expf(st - ss4[v]) * dt4[v] : 0.f; }
            u32x2 pw; pw.x = pk2(wv[0], wv[1]); pw.y = pk2(wv[2], wv[3]);
            *(LAS u32x2*)(L + SC_WM + (16 * w + fr) * SP + (16 * j + 4 * fq) * 2) = pw;
        }
        if ((w & 1) == 0) *(LAS u32x2*)(L + SC_WM + (16 * w + fr) * SP + (16 * (w + 1) + 4 * fq) * 2) = (u32x2){0u, 0u};
        LDS_WAIT(); asm volatile("" ::: "memory");
        f32x4 accO[4], accD[4];
        const int hbo = SC_HB + (c & 1) * 17408;
#pragma unroll
        for (int pt = 0; pt < 4; ++pt) { accO[pt] = (f32x4){0.f, 0.f, 0.f, 0.f}; accD[pt] = (f32x4){0.f, 0.f, 0.f, 0.f};
#pragma unroll
            for (int ks = 0; ks < 4; ++ks) { const bf16x8 X = *(const LAS bf16x8*)(L + hbo + (16 * pt + fr) * SP + (32 * ks + 8 * fq) * 2); accO[pt] = __builtin_amdgcn_mfma_f32_16x16x32_bf16(X, Cf[ks], accO[pt], 0, 0, 0); } }
        const int nks = (w >> 1) + 1;
        for (int ks = 0; ks < nks; ++ks) { const bf16x8 Y = *(const LAS bf16x8*)(L + SC_WM + (16 * w + fr) * SP + (32 * ks + 8 * fq) * 2);
#pragma unroll
            for (int pt = 0; pt < 4; ++pt) { const bf16x8 X = *(const LAS bf16x8*)(L + SC_XT + (16 * pt + fr) * SP + (32 * ks + 8 * fq) * 2); accD[pt] = __builtin_amdgcn_mfma_f32_16x16x32_bf16(X, Y, accD[pt], 0, 0, 0); } }
        MFMA_SETTLE4(accO[0], accO[1], accO[2], accO[3]);
        {
            const float et = sE[16 * w + fr]; const int mrow = m0 + 16 * w + fr; float q = 0.f;
#pragma unroll
            for (int pt = 0; pt < 4; ++pt) { const int p0 = 16 * pt + 4 * fq;
                const float zv[4] = {bflo(zr[pt].x), bfhi(zr[pt].x), bflo(zr[pt].y), bfhi(zr[pt].y)}; float y[4];
#pragma unroll
                for (int v = 0; v < 4; ++v) { const float xv = bf1(*(const LAS bf16_t*)(L + SC_XT + (p0 + v) * SP + (16 * w + fr) * 2));
                    y[v] = (accO[pt][v] * et + accD[pt][v] + Dk * xv) * zv[v]; q += y[v] * y[v]; }
                u32x2 pw; pw.x = pk2(y[0], y[1]); pw.y = pk2(y[2], y[3]);
                *(u32x2*)(ygated + (size_t)mrow * DIN + h * 64 + p0) = pw; }
            q += __shfl_xor(q, 16); q += __shfl_xor(q, 32);
            if (fq == 0) atomicAdd(ssq + (size_t)mrow * 8 + g, q);
        }
        {
            const float es = sE[127];
#pragma unroll
            for (int pt = 0; pt < 4; ++pt) hreg[pt] = hreg[pt] * es;
#pragma unroll
            for (int ks = 0; ks < 4; ++ks) {
                const f32x4 w0 = *(const LAS f32x4*)(sW + 32 * ks + 8 * fq), w1 = *(const LAS f32x4*)(sW + 32 * ks + 8 * fq + 4);
                const float wsv[8] = {w0.x, w0.y, w0.z, w0.w, w1.x, w1.y, w1.z, w1.w};
                unsigned bw[4];
#pragma unroll
                for (int jj = 0; jj < 4; ++jj) { const float lo = bf1(*(const LAS bf16_t*)(L + SC_BN + (32 * ks + 8 * fq + 2 * jj) * SP + (16 * w + fr) * 2)), hi = bf1(*(const LAS bf16_t*)(L + SC_BN + (32 * ks + 8 * fq + 2 * jj + 1) * SP + (16 * w + fr) * 2));
                    bw[jj] = pk2(lo * wsv[2 * jj], hi * wsv[2 * jj + 1]); }
                const bf16x8 Y = __builtin_bit_cast(bf16x8, (u32x4){bw[0], bw[1], bw[2], bw[3]});
#pragma unroll
                for (int pt = 0; pt < 4; ++pt) { const bf16x8 X = *(const LAS bf16x8*)(L + SC_XT + (16 * pt + fr) * SP + (32 * ks + 8 * fq) * 2); hreg[pt] = __builtin_amdgcn_mfma_f32_16x16x32_bf16(X, Y, hreg[pt], 0, 0, 0); }
            }
            MFMA_SETTLE4(hreg[0], hreg[1], hreg[2], hreg[3]);
            const int hbn = SC_HB + ((c + 1) & 1) * 17408;
#pragma unroll
            for (int pt = 0; pt < 4; ++pt)
#pragma unroll
                for (int v = 0; v < 4; ++v) *(LAS bf16_t*)(L + hbn + (16 * pt + 4 * fq + v) * SP + (16 * w + fr) * 2) = (bf16_t)f2bf(hreg[pt][v]);
        }
    }
#undef SCAN_LOAD
    float* hs = a.out + O_PSSM + (size_t)(b * NH + h) * HD * DST;
#pragma unroll
    for (int pt = 0; pt < 4; ++pt)
#pragma unroll
        for (int v = 0; v < 4; ++v) hs[(size_t)(16 * pt + 4 * fq + v) * DST + 16 * w + fr] = hreg[pt][v];
    __syncthreads();
}

__device__ __forceinline__ void scan_sample_item(const Ctx& F, int item, const Args& a, const bf16_t* proj, const bf16_t* xact, const float* dtv, bf16_t* ygated, float* ssq, LAS float* wl) {
    const int bb = item >> 6, h = item & 63, g = h >> 3, lane = F.lane;
    const int mb = MP + 4 * bb;
    const float aneg = -__expf(a.in[19][h]), Dk = a.in[20][h];
    float dt[4], sc[4], xv[4], Bv[4][2], Cv[4][2];
    { float run = 0.f;
#pragma unroll
      for (int t = 0; t < 4; ++t) { dt[t] = dtv[(size_t)(mb + t) * 64 + h]; run += dt[t] * aneg; sc[t] = run;
          const bf16_t* xr = xact + (size_t)(mb + t) * CONVD;
          xv[t] = bf1(xr[h * 64 + lane]);
          const unsigned qb = *(const unsigned*)(xr + DIN + g * 128 + 2 * lane), qc = *(const unsigned*)(xr + DIN + 1024 + g * 128 + 2 * lane);
          Bv[t][0] = bflo(qb); Bv[t][1] = bfhi(qb); Cv[t][0] = bflo(qc); Cv[t][1] = bfhi(qc); } }
    float zq[4];
#pragma unroll
    for (int t = 0; t < 4; ++t) zq[t] = bf1(proj[(size_t)(mb + t) * DPROJP + PC_Z + h * 64 + lane]);
    float yd[4];
#pragma unroll
    for (int t = 0; t < 4; ++t) { yd[t] = 0.f;
#pragma unroll
        for (int s = 0; s <= t; ++s) { const float gts = wave_sum(Cv[t][0] * Bv[s][0] + Cv[t][1] * Bv[s][1]); yd[t] += gts * __expf(sc[t] - sc[s]) * dt[s] * xv[s]; } }
    LAS float* xsl = wl; LAS float* yol = wl + 256;
    { f32x4 q; q.x = __expf(sc[3] - sc[0]) * dt[0] * xv[0]; q.y = __expf(sc[3] - sc[1]) * dt[1] * xv[1]; q.z = __expf(sc[3] - sc[2]) * dt[2] * xv[2]; q.w = dt[3] * xv[3];
      *(LAS f32x4*)(xsl + 4 * lane) = q; }
    LDS_WAIT(); asm volatile("" ::: "memory");
    const float e3 = __expf(sc[3]);
    const float* h0 = a.in[4] + (size_t)(bb * NH + h) * HD * DST + 2 * lane;
    float* h1 = a.out + O_SSSM + (size_t)(bb * NH + h) * HD * DST + 2 * lane;
    const bool b5 = (lane & 32) != 0, b4 = (lane & 16) != 0;
    f32x2 hnx[16];
#pragma unroll
    for (int k = 0; k < 16; ++k) hnx[k] = __builtin_nontemporal_load((const f32x2*)(h0 + (size_t)k * DST));
    for (int pb = 0; pb < 64; pb += 16) {
        f32x2 hvb[16];
#pragma unroll
        for (int k = 0; k < 16; ++k) hvb[k] = hnx[k];
        if (pb + 16 < 64) {
#pragma unroll
            for (int k = 0; k < 16; ++k) hnx[k] = __builtin_nontemporal_load((const f32x2*)(h0 + (size_t)(pb + 16 + k) * DST)); }
#pragma unroll
        for (int k = 0; k < 16; ++k) { const int p = pb + k; const f32x2 hv = hvb[k];
        const f32x4 xs4 = *(const LAS f32x4*)(xsl + 4 * p);
        f32x2 hn; hn.x = e3 * hv.x + xs4.x * Bv[0][0] + xs4.y * Bv[1][0] + xs4.z * Bv[2][0] + xs4.w * Bv[3][0];
        hn.y = e3 * hv.y + xs4.x * Bv[0][1] + xs4.y * Bv[1][1] + xs4.z * Bv[2][1] + xs4.w * Bv[3][1];
        __builtin_nontemporal_store(hn, (f32x2*)(h1 + (size_t)p * DST));
        const float v0 = Cv[0][0] * hv.x + Cv[0][1] * hv.y, v1 = Cv[1][0] * hv.x + Cv[1][1] * hv.y, v2 = Cv[2][0] * hv.x + Cv[2][1] * hv.y, v3 = Cv[3][0] * hv.x + Cv[3][1] * hv.y;
        float k0 = b5 ? v2 : v0, k1 = b5 ? v3 : v1; const float q0 = b5 ? v0 : v2, q1 = b5 ? v1 : v3;
        k0 += __shfl_xor(q0, 32); k1 += __shfl_xor(q1, 32);
        float kk = b4 ? k1 : k0; const float qq = b4 ? k0 : k1;
        kk += __shfl_xor(qq, 16); kk += __shfl_xor(kk, 8); kk += __shfl_xor(kk, 4); kk += __shfl_xor(kk, 2); kk += __shfl_xor(kk, 1);
        if ((lane & 15) == 0) yol[(lane >> 4) * 64 + p] = kk;
        }
    }
    LDS_WAIT(); asm volatile("" ::: "memory");
#pragma unroll
    for (int t = 0; t < 4; ++t) {
        const float z = zq[t];
        const float y = (yol[t * 64 + lane] * __expf(sc[t]) + yd[t] + Dk * xv[t]) * z;
        ygated[(size_t)(mb + t) * DIN + h * 64 + lane] = (bf16_t)f2bf(y);
        const float q = wave_sum(y * y);
        if (lane == 0) atomicAdd(ssq + (size_t)(mb + t) * 8 + g, q);
    }
    LDS_WAIT(); asm volatile("" ::: "memory");
}

__device__ __forceinline__ void scan_phase(const Ctx& F, const Args& a) {
    unsigned char* ws = a.ws;
    const bf16_t* proj = (const bf16_t*)(ws + WS_PROJ); const bf16_t* xact = (const bf16_t*)(ws + WS_XACT); const float* dtv = (const float*)(ws + WS_DTRAW);
    bf16_t* ygated = (bf16_t*)(ws + WS_YSSM); float* ssq = (float*)(ws + WS_SSQ);
    const int vcu = (F.G % 8 == 0) ? (F.bid % 8) * (F.G / 8) + F.bid / 8 : F.bid;
    const bool sample_first = ((vcu >> 3) & 1) != 0;
    LAS float* wl = (LAS float*)(F.lds + F.wave * 4096);
    if (sample_first) { for (int it = F.bid * 8 + F.wave; it < DB * NH; it += F.G * 8) scan_sample_item(F, it, a, proj, xact, dtv, ygated, ssq, wl); __syncthreads(); }
    for (int it = vcu; it < NB * NH; it += F.G) scan_prompt_item(F, it >> 6, it & 63, a, proj, xact, dtv, ygated, ssq);
    __syncthreads();
    if (!sample_first) { for (int it = F.bid * 8 + F.wave; it < DB * NH; it += F.G * 8) scan_sample_item(F, it, a, proj, xact, dtv, ygated, ssq, wl); __syncthreads(); }
}

__device__ __forceinline__ void ssm_norm_rows(const Ctx& F, bf16_t* y, const float* ssq, const float* gamma) {
    const int gw = F.bid * 8 + F.wave, NGW = F.G * 8;
    for (int m = gw; m < MT; m += NGW) {
#pragma unroll
        for (int j = 0; j < 8; ++j) { const int c = 8 * F.lane + 512 * j;
            const float rinv = 1.0f / sqrtf(ssq[(size_t)m * 8 + j] * (1.0f / 512.0f) + EPS);
            u32x4* p = (u32x4*)(y + (size_t)m * DIN + c); const u32x4 r = *p;
            const f32x4 g0 = *(const f32x4*)(gamma + c), g1 = *(const f32x4*)(gamma + c + 4);
            u32x4 o; o.x = pk2(bflo(r.x) * rinv * g0.x, bfhi(r.x) * rinv * g0.y); o.y = pk2(bflo(r.y) * rinv * g0.z, bfhi(r.y) * rinv * g0.w);
            o.z = pk2(bflo(r.z) * rinv * g1.x, bfhi(r.z) * rinv * g1.y); o.w = pk2(bflo(r.w) * rinv * g1.z, bfhi(r.w) * rinv * g1.w);
            *p = o; }
    }
}

__device__ __forceinline__ void tail_tiles_merge(const Ctx& F, const float* partA, const float* partB, bf16_t* merged) {
    pg8::StaticOrder Sa; Sa.init(MT, DM, DM, F.G, F.bid, true); pg8::StaticOrder Sb; Sb.init(MT, DM, DIN, F.G, F.bid, true); if (Sa.S <= 1) return;
    for (int j = F.bid; j < Sa.tail * 8; j += F.G) { const int un = j >> 3, sub = j & 7; Unit u; Sa.decode(Sa.full + un, u);
        for (int i = F.tid; i < 32 * 64; i += 512) { const int lr = sub * 32 + (i >> 6), lc = (i & 63) * 4; f32x4 v = (f32x4){0.f, 0.f, 0.f, 0.f};
            if (Sa.S == 16 && Sb.S == 16) {
                const bf16_t* pa_ = (const bf16_t*)partA + (size_t)(un * 16) * 65536 + lr * 256 + lc; const bf16_t* pb_ = (const bf16_t*)partB + (size_t)(un * 16) * 65536 + lr * 256 + lc;
                u32x2 pw[32];
#pragma unroll
                for (int pc = 0; pc < 16; ++pc) { pw[pc] = *(const u32x2*)(pa_ + (size_t)pc * 65536); pw[16 + pc] = *(const u32x2*)(pb_ + (size_t)pc * 65536); }
#pragma unroll
                for (int pc = 0; pc < 32; ++pc) v += (f32x4){bflo(pw[pc].x), bfhi(pw[pc].x), bflo(pw[pc].y), bfhi(pw[pc].y)};
            } else {
            for (int pc = 0; pc < Sa.S; ++pc) { const u32x2 pw = *(const u32x2*)((const bf16_t*)partA + (size_t)(un * Sa.S + pc) * 65536 + lr * 256 + lc); v += (f32x4){bflo(pw.x), bfhi(pw.x), bflo(pw.y), bfhi(pw.y)}; }
            for (int pc = 0; pc < Sb.S; ++pc) { const u32x2 pw = *(const u32x2*)((const bf16_t*)partB + (size_t)(un * Sb.S + pc) * 65536 + lr * 256 + lc); v += (f32x4){bflo(pw.x), bfhi(pw.x), bflo(pw.y), bfhi(pw.y)}; }
            }
            u32x2 w; w.x = pk2(v.x, v.y); w.y = pk2(v.z, v.w); *(u32x2*)(merged + (size_t)(u.pm * 256 + lr) * DM + u.pn * 256 + lc) = w; } }
}
__device__ __forceinline__ int tail_map_build(const Ctx& F, int K, LAS int* tmap) {
    pg8::StaticOrder St; St.init(MT, DM, K, F.G, F.bid, true);
    __syncthreads();
    for (int i = F.tid; i < 34 * 8; i += 512) tmap[i] = -1;
    __syncthreads();
    if (St.S > 1 && F.tid < St.tail) { Unit u; St.decode(St.full + F.tid, u); tmap[u.pm * 8 + u.pn] = F.tid; }
    __syncthreads();
    return St.S;
}

#define XB_TMO      128
#define XB_XCNT(j)  (256  + 64 * (j))
#define XB_XSUB(j)  (1280 + 64 * (j))
#define XB_XGEN(j)  (2304 + 64 * (j))
#define XB_TOP      3328
#define XB_TOPGEN   3392
#define XCD_BAR_WORDS 3456
#define XB_SPIN_CAP (1u << 22)
__device__ __forceinline__ unsigned xb_ld(unsigned* p)              { return __hip_atomic_load(p, __ATOMIC_RELAXED, __HIP_MEMORY_SCOPE_AGENT); }
__device__ __forceinline__ unsigned xb_add(unsigned* p, unsigned v) { return __hip_atomic_fetch_add(p, v, __ATOMIC_RELAXED, __HIP_MEMORY_SCOPE_AGENT); }
__device__ __forceinline__ unsigned xb_xcc_id() { return (unsigned)__builtin_amdgcn_s_getreg((3 << 11) | 20) & 0xFu; }
#define XB_SPIN(cond, bar) do { unsigned _sp = 0; while (cond) { __builtin_amdgcn_s_sleep(1); \
    if ((++_sp & 255u) == 0u) { if (xb_ld(&(bar)[XB_TMO])) break; if (_sp > XB_SPIN_CAP) { atomicAdd(&(bar)[XB_TMO], 1u); break; } } } } while (0)
struct XcdBarrier { unsigned* bar; unsigned x; volatile LAS unsigned* st; };
__device__ __forceinline__ XcdBarrier xcd_barrier_post(unsigned* bar, volatile LAS unsigned* st) {
    XcdBarrier b; b.bar = bar; b.x = xb_xcc_id(); b.st = st;
    if (threadIdx.x == 0) (void)xb_add(&bar[XB_XCNT(b.x)], 1u);
    return b;
}
__device__ __forceinline__ void xcd_barrier_complete(unsigned* bar, unsigned x, unsigned& nloc, unsigned& nx) {
    const unsigned G = gridDim.x * gridDim.y * gridDim.z;
    unsigned sum, cnt, mine, sp = 0u;
    for (;;) {
        sum = 0u; cnt = 0u; mine = 0u;
#pragma unroll
        for (unsigned j = 0; j < 16; ++j) { const unsigned c = xb_ld(&bar[XB_XCNT(j)]); sum += c; cnt += (c > 0u) ? 1u : 0u; mine = (j == x) ? c : mine; }
        if (sum == G) break;
        __builtin_amdgcn_s_sleep(1);
        if ((++sp & 255u) == 0u) { if (xb_ld(&bar[XB_TMO])) break; if (sp > XB_SPIN_CAP) { atomicAdd(&bar[XB_TMO], 1u); break; } }
    }
    nloc = mine > 0u ? mine : 1u; nx = cnt > 0u ? cnt : 1u;
}
__device__ __forceinline__ void xcd_barrier(const XcdBarrier& b) {
    asm volatile("s_waitcnt vmcnt(0)" ::: "memory");
    __syncthreads();
    if (threadIdx.x == 0) {
        unsigned* bar = b.bar;
        __builtin_amdgcn_s_waitcnt(0);
        unsigned nloc = b.st[0], nx = b.st[1];
        if (nloc == 0u) { xcd_barrier_complete(bar, b.x, nloc, nx); b.st[0] = nloc; b.st[1] = nx; }
        const unsigned old = xb_add(&bar[XB_XSUB(b.x)], 1u);
        const unsigned gen = old / nloc;
        if (old + 1u == (gen + 1u) * nloc) {
            __builtin_amdgcn_fence(__ATOMIC_RELEASE, "agent");
            asm volatile("s_waitcnt vmcnt(0)" ::: "memory");
            const unsigned og = xb_add(&bar[XB_TOP], 1u);
            const unsigned tg = og / nx;
            if (og + 1u == (tg + 1u) * nx) xb_add(&bar[XB_TOPGEN], 1u);
            else XB_SPIN(xb_ld(&bar[XB_TOPGEN]) == tg, bar);
            __builtin_amdgcn_fence(__ATOMIC_ACQUIRE, "agent");
            xb_add(&bar[XB_XGEN(b.x)], 1u);
            asm volatile("s_waitcnt vmcnt(0)" ::: "memory");
        } else {
            XB_SPIN(xb_ld(&bar[XB_XGEN(b.x)]) == gen, bar);
            __builtin_amdgcn_fence(__ATOMIC_ACQUIRE, "agent");
            asm volatile("s_waitcnt vmcnt(0)" ::: "memory");
        }
    }
    __syncthreads();
}

constexpr int NPHASE = 18;
__global__ void __launch_bounds__(512, 2) fwd_megakernel(Args args) {
    extern __shared__ __attribute__((aligned(16))) unsigned char lds_raw[];
    Ctx F; F.lds = (LAS unsigned char*)lds_raw; F.tid = threadIdx.x; F.lane = F.tid & 63; F.wave = __builtin_amdgcn_readfirstlane(F.tid >> 6); F.G = gridDim.x; F.bid = blockIdx.x;
    unsigned char* ws = args.ws;
    const int lo = args.ph_lo, hi = args.ph_hi;
#define IN(k) (lo <= (k) && (k) < hi)
    { volatile LAS unsigned* st = (volatile LAS unsigned*)(F.lds + LDS_BYTES - 64); if (F.tid < 2) st[F.tid] = 0u; }
    __syncthreads();
    XcdBarrier xbar; xbar.bar = nullptr; xbar.x = 0; xbar.st = nullptr;
    if (args.coop) xbar = xcd_barrier_post((unsigned*)(ws + WS_CTL) + 4096, (volatile LAS unsigned*)(F.lds + LDS_BYTES - 64));
    if (args.coop == 2) cg::this_grid().sync();
#define SEAM(k) do { if (IN(k) && IN((k) + 1)) xcd_barrier(xbar); } while (0)
    float* mods = (float*)(ws + WS_MODS); bf16_t* act = (bf16_t*)(ws + WS_ACT); float* hbuf = (float*)(ws + WS_H); bf16_t* hmid = (bf16_t*)(ws + WS_HMID);
    bf16_t* proj = (bf16_t*)(ws + WS_PROJ); float* tmp = (float*)(ws + WS_TMP); bf16_t* merged = (bf16_t*)(ws + WS_ACT);
    pg8::StaticOrder S;
    LAS int* tmapL = (LAS int*)(F.lds + 140000);

    if (IN(0)) { p0_prologue(F, args, 0, 0, F.G); } SEAM(0);
    if (IN(1)) {
        pg8::Gemm g{(const bf16_t*)(ws + WS_AC), (const bf16_t*)(ws + WS_WADA), 256, NMOD, DM, 0, 0}; S.init(256, NMOD, DM, F.G, F.bid, false);
        EpiMods E{mods};
        constexpr int NQ = NMOD / 256;
        pg8::Gemm g2{(const bf16_t*)(ws + WS_WBP), (const bf16_t*)(ws + WS_WPOOL), DM, DM, 512, 2, (size_t)512 * 2, DM}; EpiPlain E2{(bf16_t*)(ws + WS_YPOOL)};
        if (F.G >= NQ + 64) {
            if (F.bid < NQ) { pg8::gemm_phase<EpiMods>(F.lds, g, S, E); __syncthreads(); pg8::StaticOrder S2; S2.init(DM, DM, 512, NQ, F.bid, false); pg8::gemm_phase<EpiPlain>(F.lds, g2, S2, E2); }
            else p0_prologue(F, args, 1, NQ, F.G - NQ);
        } else { pg8::gemm_phase<EpiMods>(F.lds, g, S, E); __syncthreads(); pg8::StaticOrder S2; S2.init(DM, DM, 512, F.G, F.bid, false); pg8::gemm_phase<EpiPlain>(F.lds, g2, S2, E2); __syncthreads(); p0_prologue(F, args, 1, 0, F.G); }
    } SEAM(1);
    if (IN(2)) { norm_mod_rows(F, args.in[0], args.in[1], args.in[9], mods, 0 * DM, 1 * DM, act, nullptr, nullptr, nullptr, 1, nullptr); } SEAM(2);
    if (IN(3)) {
        pg8::Gemm g{act, (const bf16_t*)(ws + WS_W13A), MT, 2 * DFF, DM, 0, 0}; S.init(MT, 2 * DFF, DM, F.G, F.bid, false);
        EpiSwiglu E{hmid}; pg8::gemm_phase<EpiSwiglu>(F.lds, g, S, E);
        if (S.tail > 0 && F.bid >= S.tail) { __syncthreads(); convert_range(F, args, P0_EARLY + (F.bid - S.tail) * 8 + F.wave, P0_DEFER_A, (F.G - S.tail) * 8); }
        else if (S.tail == 0 && F.bid == 0) { __syncthreads(); convert_range(F, args, P0_EARLY + F.wave, P0_DEFER_A, 8); }
    } SEAM(3);
    if (IN(4)) {
        pg8::Gemm g{hmid, (const bf16_t*)(ws + WS_W2A), MT, DM, DFF, 0, 0}; S.init(MT, DM, DFF, F.G, F.bid, true);
        EpiResid E{hbuf, mods + 2 * DM, 0.5f, (float*)(ws + WS_TMP), args.in[0], args.in[1]}; pg8::gemm_phase<EpiResid>(F.lds, g, S, E);
    } SEAM(4);
    if (IN(5)) { const int Sp = tail_map_build(F, DFF, tmapL); norm_mod_rows(F, hbuf, hbuf + (size_t)MP * DM, args.in[12], mods, 3 * DM, 4 * DM, act, args.in[0], args.in[1], (const float*)(ws + WS_TMP), Sp, tmapL); } SEAM(5);
    if (IN(6)) {
        pg8::Gemm g{act, (const bf16_t*)(ws + WS_WIN), MT, DPROJP, DM, 0, 0}; S.init(MT, DPROJP, DM, F.G, F.bid, false);
        EpiProj E{proj, (float*)(ws + WS_DTRAW)}; pg8::gemm_phase<EpiProj>(F.lds, g, S, E);
        if (S.tail > 0 && F.bid >= S.tail) { __syncthreads(); convert_range(F, args, P0_DEFER_A + (F.bid - S.tail) * 8 + F.wave, P0_NITEMS, (F.G - S.tail) * 8); }
        else if (S.tail == 0 && F.bid == 0) { __syncthreads(); convert_range(F, args, P0_DEFER_A + F.wave, P0_NITEMS, 8); }
    } SEAM(6);
    if (IN(7)) { prepass_phase(F, args); } SEAM(7);
    if (IN(8)) { scan_phase(F, args); } SEAM(8);
    if (IN(9)) {
        ssm_norm_rows(F, (bf16_t*)(ws + WS_YSSM), (const float*)(ws + WS_SSQ), args.in[21]);
    }
    if (IN(10)) {
        pg8::Gemm g{(const bf16_t*)(ws + WS_POOLED), (const bf16_t*)(ws + WS_YPOOL), MT, DM, DM, 0, 0}; S.init(MT, DM, DM, F.G, F.bid, true);
        EpiGate<false> E{proj, PC_GP, tmp, nullptr, (float*)(ws + WS_W13A)}; pg8::gemm_phase<EpiGate<false>>(F.lds, g, S, E);
    } SEAM(10);
    if (IN(11)) {
        pg8::Gemm g{(const bf16_t*)(ws + WS_YSSM), (const bf16_t*)(ws + WS_WBS), MT, DM, DIN, 0, 0}; S.init(MT, DM, DIN, F.G, F.bid, true);
        EpiGate<true> E{proj, PC_GS, tmp, merged, (float*)(ws + WS_WIN)}; pg8::gemm_phase<EpiGate<true>>(F.lds, g, S, E);
    } SEAM(11);
    if (IN(12)) { tail_tiles_merge(F, (const float*)(ws + WS_W13A), (const float*)(ws + WS_WIN), merged); } SEAM(12);
    if (IN(13)) {
        pg8::Gemm g{merged, (const bf16_t*)(ws + WS_WOUT), MT, DM, DM, 0, 0}; S.init(MT, DM, DM, F.G, F.bid, true);
        EpiResid E{hbuf, mods + 5 * DM, 1.0f, (float*)(ws + WS_W13A), nullptr, nullptr}; pg8::gemm_phase<EpiResid>(F.lds, g, S, E);
    } SEAM(13);
    if (IN(14)) { const int Sp = tail_map_build(F, DM, tmapL); norm_mod_rows(F, hbuf, hbuf + (size_t)MP * DM, args.in[25], mods, 6 * DM, 7 * DM, act, nullptr, nullptr, (const float*)(ws + WS_W13A), Sp, tmapL); } SEAM(14);
    if (IN(15)) {
        pg8::Gemm g{act, (const bf16_t*)(ws + WS_W13B), MT, 2 * DFF, DM, 0, 0}; S.init(MT, 2 * DFF, DM, F.G, F.bid, false);
        EpiSwiglu E{hmid}; pg8::gemm_phase<EpiSwiglu>(F.lds, g, S, E);
    } SEAM(15);
    if (IN(16)) {
        pg8::Gemm g{hmid, (const bf16_t*)(ws + WS_W2B), MT, DM, DFF, 0, 0}; S.init(MT, DM, DFF, F.G, F.bid, true);
        EpiResid E{hbuf, mods + 8 * DM, 0.5f, (float*)(ws + WS_W13A), nullptr, nullptr}; pg8::gemm_phase<EpiResid>(F.lds, g, S, E);
    } SEAM(16);
    if (IN(17)) { const int Sp = tail_map_build(F, DFF, tmapL); final_norm_rows(F, hbuf, args.in[28], args.out + O_Y, (const float*)(ws + WS_W13A), Sp, tmapL); }
#undef IN
#undef SEAM
}

extern "C" void kernel_launch(void* const* d_in, const int* in_sizes, int n_in, void* d_out, int out_size, void* d_ws, size_t ws_size, hipStream_t stream) {
    static int grid = 0;
    if (grid == 0) {
        if (n_in != 29 || (size_t)out_size != O_END || ws_size < WS_END) { fprintf(stderr, "kernel_launch: unexpected shapes: n_in %d out %d ws %zu (need %zu)\n", n_in, out_size, ws_size, (size_t)WS_END); grid = -1; return; }
        int dev = 0, cus = 0, per_cu = 0;
        hipGetDevice(&dev); hipDeviceGetAttribute(&cus, hipDeviceAttributeMultiprocessorCount, dev);
        if (hipFuncSetAttribute((const void*)fwd_megakernel, hipFuncAttributeMaxDynamicSharedMemorySize, LDS_BYTES) != hipSuccess) { fprintf(stderr, "kernel_launch: hipFuncSetAttribute failed\n"); grid = -1; return; }
        if (hipOccupancyMaxActiveBlocksPerMultiprocessor(&per_cu, (const void*)fwd_megakernel, 512, LDS_BYTES) != hipSuccess || per_cu < 1) { fprintf(stderr, "kernel_launch: occupancy query says %d\n", per_cu); per_cu = 1; }
        (void)hipGetLastError();
        grid = cus;
    }
    if (grid < 0) return;
    hipMemsetAsync((char*)d_ws + WS_CTL, 0, CTL_ZERO_BYTES, stream);
    Args a{};
    for (int i = 0; i < 29; ++i) a.in[i] = (const float*)d_in[i];
    a.out = (float*)d_out; a.ws = (unsigned char*)d_ws;
#if MK_N_LAUNCHES == 1
    a.ph_lo = 0; a.ph_hi = NPHASE; a.coop = 1;
    void* kargs[] = {&a};
    hipError_t e = hipLaunchCooperativeKernel((const void*)fwd_megakernel, dim3(grid), dim3(512), kargs, LDS_BYTES, stream);
    if (e != hipSuccess) fprintf(stderr, "cooperative launch failed: %s (grid %d)\n", hipGetErrorString(e), grid);
#else
    for (int p = 0; p < NPHASE; ++p) { a.ph_lo = p; a.ph_hi = p + 1; a.coop = 0; hipLaunchKernelGGL(fwd_megakernel, dim3(grid), dim3(512), LDS_BYTES, stream, a); }
#endif
}
```
